# Optimizing an MI355X kernel written in HIP

```python
import math
import jax, jax.numpy as jnp
from jax import lax
import numpy as np

D_MODEL = 2048
BATCH = 1
SEQ = 8192
DEPTH = 4

N_MIXERS = 3
N_A = (DEPTH + 2) // 3
N_B = (DEPTH + 1) // 3
N_C = DEPTH // 3
HEAD_DIM = 128
ROPE_THETA = 500000.0
PARTIAL_ROT = HEAD_DIM // 4
NORM_EPS = 1e-6
NEG = -1e30
A_HEADS = D_MODEL // HEAD_DIM
A_KV_HEADS = A_HEADS // 4
A_HALF_WINDOW = 128
B_HEADS = D_MODEL // HEAD_DIM
B_Q_RANK = 512
B_KV_RANK = 512
B_NOPE = 128
B_ROPE = 64
B_V = 128
B_QK = B_NOPE + B_ROPE
C_PATTERNS = ((128, 1), (512, 4), (2048, 16))
C_GROUPS = len(C_PATTERNS)
C_HEADS = D_MODEL // HEAD_DIM
D_FF = ((8 * D_MODEL // 3 + 255) // 256) * 256
PLE_DIM = 256
Q_BLOCK = 128

kernel_name = "interleaved_hybrid_encoder_swa_mla_dilated"


def rms_norm(x, g):
    xf = x.astype(jnp.float32)
    y = xf * lax.rsqrt(jnp.mean(xf * xf, axis=-1, keepdims=True) + NORM_EPS)
    return (y * g.astype(jnp.float32)).astype(x.dtype)


def rope(x, pos, rot_dim):
    half = rot_dim // 2
    inv = ROPE_THETA ** (-jnp.arange(half, dtype=jnp.float32) * 2.0 / rot_dim)
    ang = pos.astype(jnp.float32)[..., None] * inv
    cos = jnp.cos(ang)[:, :, None, :]
    sin = jnp.sin(ang)[:, :, None, :]
    xr = x[..., :rot_dim].astype(jnp.float32)
    x1, x2 = xr[..., :half], xr[..., half:]
    rot = jnp.concatenate([x1 * cos - x2 * sin, x2 * cos + x1 * sin], axis=-1).astype(x.dtype)
    return jnp.concatenate([rot, x[..., rot_dim:]], axis=-1)


def banded_attention(q, k, v, half_w, sink=None):
    N, L, Hq, hd = q.shape
    Hkv = k.shape[2]
    G = Hq // Hkv
    blk = half_w
    nb = -(-L // blk)
    Lp = nb * blk
    pad = Lp - L
    q = jnp.pad(q, ((0, 0), (0, pad), (0, 0), (0, 0)))
    k = jnp.pad(k, ((0, 0), (blk, pad + blk), (0, 0), (0, 0)))
    v = jnp.pad(v, ((0, 0), (blk, pad + blk), (0, 0), (0, 0)))
    kb = k.reshape(N, nb + 2, blk, Hkv, hd)
    vb = v.reshape(N, nb + 2, blk, Hkv, hd)
    kn = jnp.concatenate([kb[:, :-2], kb[:, 1:-1], kb[:, 2:]], axis=2)
    vn = jnp.concatenate([vb[:, :-2], vb[:, 1:-1], vb[:, 2:]], axis=2)
    qb = q.reshape(N, nb, blk, Hkv, G, hd)
    s = jnp.einsum('nbqkgd,nbjkd->nbkgqj', qb, kn,
                   preferred_element_type=jnp.float32) * (1.0 / math.sqrt(hd))
    qpos = jnp.arange(Lp).reshape(nb, blk)
    kpos = (jnp.arange(nb)[:, None] - 1) * blk + jnp.arange(3 * blk)[None, :]
    valid = ((jnp.abs(qpos[:, :, None] - kpos[:, None, :]) <= half_w)
             & (kpos >= 0)[:, None, :] & (kpos < L)[:, None, :])
    s = jnp.where(valid[None, :, None, None], s, NEG)
    m = jnp.max(s, axis=-1)
    if sink is not None:
        sink_b = sink.astype(jnp.float32).reshape(1, 1, Hkv, G, 1)
        m = jnp.maximum(m, sink_b)
    pr = jnp.exp(s - m[..., None])
    denom = jnp.sum(pr, axis=-1)
    if sink is not None:
        denom = denom + jnp.exp(sink_b - m)
    o = jnp.einsum('nbkgqj,nbjkd->nbqkgd', pr.astype(v.dtype), vn,
                   preferred_element_type=jnp.float32)
    o = o / denom.transpose(0, 1, 4, 2, 3)[..., None]
    lse = (m + jnp.log(denom)).transpose(0, 1, 4, 2, 3).reshape(N, Lp, Hq)[:, :L]
    o = o.reshape(N, Lp, Hq, hd)[:, :L].astype(q.dtype)
    return o, lse


def dense_attention(q, k, v):
    B, S, H, dq = q.shape
    dv = v.shape[-1]
    nq = S // Q_BLOCK
    scale = 1.0 / math.sqrt(dq)
    qb = q.reshape(B, nq, Q_BLOCK, H, dq).transpose(1, 0, 2, 3, 4)

    def one_block(qi):
        s = jnp.einsum('bqhd,bkhd->bhqk', qi, k, preferred_element_type=jnp.float32) * scale
        pr = jax.nn.softmax(s, axis=-1)
        return jnp.einsum('bhqk,bkhd->bqhd', pr.astype(v.dtype), v)

    o = lax.map(one_block, qb)
    return o.transpose(1, 0, 2, 3, 4).reshape(B, S, H, dv)


def mixer_a(hn, pos, w_in, gq, gk, sink, w_o):
    B, S, _ = hn.shape
    qkv = hn @ w_in
    nq = A_HEADS * HEAD_DIM
    nk = A_KV_HEADS * HEAD_DIM
    q = qkv[..., :nq].reshape(B, S, A_HEADS, HEAD_DIM)
    k = qkv[..., nq:nq + nk].reshape(B, S, A_KV_HEADS, HEAD_DIM)
    v = qkv[..., nq + nk:].reshape(B, S, A_KV_HEADS, HEAD_DIM)
    q = rope(rms_norm(q, gq), pos, PARTIAL_ROT)
    k = rope(rms_norm(k, gk), pos, PARTIAL_ROT)
    o, _ = banded_attention(q, k, v, A_HALF_WINDOW, sink)
    return o.reshape(B, S, nq) @ w_o


def mixer_b(hn, pos, w_in, g_qlat, g_kvlat, w_q_up, w_kv_up, gq, gk, w_o):
    B, S, _ = hn.shape
    lat = hn @ w_in
    q_lat = lat[..., :B_Q_RANK]
    kv_lat = lat[..., B_Q_RANK:B_Q_RANK + B_KV_RANK]
    k_rope = lat[..., B_Q_RANK + B_KV_RANK:]
    q = (rms_norm(q_lat, g_qlat) @ w_q_up).reshape(B, S, B_HEADS, B_QK)
    kv = (rms_norm(kv_lat, g_kvlat) @ w_kv_up).reshape(B, S, B_HEADS, B_NOPE + B_V)
    k_nope, v = kv[..., :B_NOPE], kv[..., B_NOPE:]
    k = jnp.concatenate(
        [k_nope, jnp.broadcast_to(k_rope[:, :, None, :], (B, S, B_HEADS, B_ROPE))], axis=-1)
    q = rms_norm(q, gq)
    k = rms_norm(k, gk)
    q = jnp.concatenate([q[..., :B_NOPE], rope(q[..., B_NOPE:], pos, B_ROPE)], axis=-1)
    k = jnp.concatenate([k[..., :B_NOPE], rope(k[..., B_NOPE:], pos, B_ROPE)], axis=-1)
    o = dense_attention(q, k, v)
    return o.reshape(B, S, B_HEADS * B_V) @ w_o


def to_chains(x, dil):
    B, S, H, d = x.shape
    return x.reshape(B, S // dil, dil, H, d).transpose(0, 2, 1, 3, 4).reshape(B * dil, S // dil, H, d)


def from_chains(x, B, dil):
    N, Lc = x.shape[0], x.shape[1]
    rest = x.shape[2:]
    x = x.reshape((B, dil, Lc) + rest)
    x = jnp.moveaxis(x, 1, 2)
    return x.reshape((B, Lc * dil) + rest)


def mixer_c(hn, pos, w_in, gq, gk, w_o):
    B, S, _ = hn.shape
    nq = C_GROUPS * C_HEADS * HEAD_DIM
    nkv = C_HEADS * HEAD_DIM
    qkv = hn @ w_in
    q = qkv[..., :nq].reshape(B, S, C_GROUPS * C_HEADS, HEAD_DIM)
    k = qkv[..., nq:nq + nkv].reshape(B, S, C_HEADS, HEAD_DIM)
    v = qkv[..., nq + nkv:].reshape(B, S, C_HEADS, HEAD_DIM)
    q = rope(rms_norm(q, gq), pos, PARTIAL_ROT)
    k = rope(rms_norm(k, gk), pos, PARTIAL_ROT)
    outs, lses = [], []
    for g, (window, dil) in enumerate(C_PATTERNS):
        qg = q[:, :, g * C_HEADS:(g + 1) * C_HEADS]
        half_steps = window // 2 // dil
        o, lse = banded_attention(to_chains(qg, dil), to_chains(k, dil), to_chains(v, dil), half_steps)
        outs.append(from_chains(o, B, dil))
        lses.append(from_chains(lse, B, dil))
    w = jax.nn.softmax(jnp.stack(lses, axis=0), axis=0)
    o = jnp.sum(w[..., None] * jnp.stack(outs, axis=0).astype(jnp.float32), axis=0).astype(hn.dtype)
    return o.reshape(B, S, nkv) @ w_o


def swiglu(hn, wg, wu, wd):
    return (jax.nn.silu(hn @ wg) * (hn @ wu)) @ wd


def setup_inputs(seed: int = 0) -> dict:
    key = jax.random.key(seed)
    ks = iter(jax.random.split(key, 40))
    f32 = jnp.float32

    def nrm(shape, fan_in):
        return jax.random.normal(next(ks), shape, f32) * (fan_in ** -0.5)

    def gain(shape):
        return 1.0 + 0.05 * jax.random.normal(next(ks), shape, f32)

    x = jax.random.normal(next(ks), (BATCH, SEQ, D_MODEL), f32)
    p = jax.random.normal(next(ks), (DEPTH, BATCH, SEQ, PLE_DIM), f32)
    offs = jax.random.randint(next(ks), (BATCH, 1), 0, 4096, dtype=jnp.int32)
    positions = jnp.arange(SEQ, dtype=jnp.int32)[None, :] + offs
    a_in = A_HEADS * HEAD_DIM + 2 * A_KV_HEADS * HEAD_DIM
    b_in = B_Q_RANK + B_KV_RANK + B_ROPE
    c_in = C_GROUPS * C_HEADS * HEAD_DIM + 2 * C_HEADS * HEAD_DIM
    return {
        "x": x,
        "p": p,
        "positions": positions,
        "g_mix": gain((DEPTH, D_MODEL)),
        "g_ffn": gain((DEPTH, D_MODEL)),
        "g_ple": gain((DEPTH, D_MODEL)),
        "w_ple_gate": nrm((DEPTH, D_MODEL, D_MODEL), D_MODEL),
        "w_ple_proj": nrm((DEPTH, PLE_DIM, D_MODEL), PLE_DIM),
        "w_ffn_gate": nrm((DEPTH, D_MODEL, D_FF), D_MODEL),
        "w_ffn_up": nrm((DEPTH, D_MODEL, D_FF), D_MODEL),
        "w_ffn_down": nrm((DEPTH, D_FF, D_MODEL), D_FF),
        "a_w_in": nrm((N_A, D_MODEL, a_in), D_MODEL),
        "a_q_norm": gain((N_A, HEAD_DIM)),
        "a_k_norm": gain((N_A, HEAD_DIM)),
        "a_sink": 0.5 * jax.random.normal(next(ks), (N_A, A_HEADS), f32),
        "a_w_o": nrm((N_A, A_HEADS * HEAD_DIM, D_MODEL), A_HEADS * HEAD_DIM),
        "b_w_in": nrm((N_B, D_MODEL, b_in), D_MODEL),
        "b_q_lat_norm": gain((N_B, B_Q_RANK)),
        "b_kv_lat_norm": gain((N_B, B_KV_RANK)),
        "b_w_q_up": nrm((N_B, B_Q_RANK, B_HEADS * B_QK), B_Q_RANK),
        "b_w_kv_up": nrm((N_B, B_KV_RANK, B_HEADS * (B_NOPE + B_V)), B_KV_RANK),
        "b_q_norm": gain((N_B, B_QK)),
        "b_k_norm": gain((N_B, B_QK)),
        "b_w_o": nrm((N_B, B_HEADS * B_V, D_MODEL), B_HEADS * B_V),
        "c_w_in": nrm((N_C, D_MODEL, c_in), D_MODEL),
        "c_q_norm": gain((N_C, HEAD_DIM)),
        "c_k_norm": gain((N_C, HEAD_DIM)),
        "c_w_o": nrm((N_C, C_HEADS * HEAD_DIM, D_MODEL), C_HEADS * HEAD_DIM),
    }


def reference(x, p, positions, g_mix, g_ffn, g_ple, w_ple_gate, w_ple_proj,
              w_ffn_gate, w_ffn_up, w_ffn_down,
              a_w_in, a_q_norm, a_k_norm, a_sink, a_w_o,
              b_w_in, b_q_lat_norm, b_kv_lat_norm, b_w_q_up, b_w_kv_up, b_q_norm, b_k_norm, b_w_o,
              c_w_in, c_q_norm, c_k_norm, c_w_o):
    h = x
    for i in range(DEPTH):
        kind, slot = i % N_MIXERS, i // N_MIXERS
        hn = rms_norm(h, g_mix[i])
        if kind == 0:
            mix = mixer_a(hn, positions, a_w_in[slot], a_q_norm[slot], a_k_norm[slot],
                          a_sink[slot], a_w_o[slot])
        elif kind == 1:
            mix = mixer_b(hn, positions, b_w_in[slot], b_q_lat_norm[slot], b_kv_lat_norm[slot],
                          b_w_q_up[slot], b_w_kv_up[slot], b_q_norm[slot], b_k_norm[slot],
                          b_w_o[slot])
        else:
            mix = mixer_c(hn, positions, c_w_in[slot], c_q_norm[slot], c_k_norm[slot], c_w_o[slot])
        h = h + mix
        h = h + swiglu(rms_norm(h, g_ffn[i]), w_ffn_gate[i], w_ffn_up[i], w_ffn_down[i])
        gate = jax.nn.sigmoid(rms_norm(h, g_ple[i]) @ w_ple_gate[i])
        h = h + gate * (p[i] @ w_ple_proj[i])
    return h
```

```cpp
#include <hip/hip_runtime.h>
#include <hip/hip_cooperative_groups.h>
#include <cstdio>
#include <cmath>
#include <cstdint>
namespace cg = cooperative_groups;

#define LAS __attribute__((address_space(3)))
typedef unsigned short bf16_t;
typedef short bf16x8 __attribute__((ext_vector_type(8)));
typedef short s16x4 __attribute__((ext_vector_type(4)));
typedef float f32x4 __attribute__((ext_vector_type(4)));
typedef float f32x2 __attribute__((ext_vector_type(2)));
typedef float f32x16 __attribute__((ext_vector_type(16)));
typedef unsigned u32x4 __attribute__((ext_vector_type(4)));
typedef unsigned u32x2 __attribute__((ext_vector_type(2)));

constexpr int SEQ = 8192, DM = 2048, FF = 5632, PLE = 256, NLAYER = 4;
constexpr float EPS = 1e-6f;
constexpr int NJOBS = 30, NJOBS_MAIN = 21;

constexpr size_t SZ_WGU = 11264ull * 2048 * 2, SZ_WD = 2048ull * 5632 * 2, SZ_WPG = 2048ull * 2048 * 2, SZ_WPP = 2048ull * 256 * 2;
constexpr size_t SZ_LAYER = SZ_WGU + SZ_WD + SZ_WPG + SZ_WPP;
constexpr size_t SZ_WO = 2048ull * 2048 * 2, SZ_AIN = 3072ull * 2048 * 2, SZ_BIN = 1280ull * 2048 * 2, SZ_BQ = 3072ull * 512 * 2, SZ_BKV = 4096ull * 512 * 2, SZ_CIN = 10240ull * 2048 * 2;
constexpr size_t OFF_WL = 0;
constexpr size_t OFF_A = OFF_WL + 4 * SZ_LAYER;
constexpr size_t OFF_B = OFF_A + 2 * (SZ_AIN + SZ_WO);
constexpr size_t OFF_C = OFF_B + SZ_BIN + SZ_BQ + SZ_BKV + SZ_WO;
constexpr size_t OFF_WEND = OFF_C + SZ_CIN + SZ_WO;
constexpr size_t OFF_HB = OFF_WEND;
constexpr size_t OFF_PBF = OFF_HB + 8192ull * 2048 * 2;
constexpr size_t OFF_PP = OFF_PBF + 4ull * 8192 * 256 * 2;
constexpr size_t OFF_ATT = OFF_PP + 8192ull * 2048 * 2;
constexpr size_t OFF_OG = OFF_ATT + 8192ull * 2048 * 2;
constexpr size_t OFF_LSE = OFF_OG + 3ull * 8192 * 2048 * 2;
constexpr size_t OFF_SS = OFF_LSE + 3ull * 8192 * 16 * 4;
constexpr size_t OFF_R32 = OFF_SS + 16ull * 8192 * 4;
constexpr size_t OFF_R64 = OFF_R32 + 8192ull * 16 * 8;
constexpr size_t OFF_BAR = OFF_R64 + 8192ull * 32 * 8;
constexpr size_t OFF_R1 = OFF_BAR + 16384;
constexpr size_t R1_LAT = 0, R1_QRAW = 3ull * 8192 * 512 * 2, R1_KVRAW = R1_QRAW + 8192ull * 3072 * 2, R1_KB = R1_KVRAW + 8192ull * 4096 * 2, R1_END = R1_KB + 8192ull * 3072 * 2;
constexpr size_t WS_END = OFF_R1 + R1_END;
static_assert(8192ull * 10240 * 2 <= R1_END && 8192ull * 5632 * 2 <= R1_END, "R1 too small");

struct WJob { const float* src; const float* gain; unsigned long long dst_off; int K, N, Npad, blk, blkstride, boff; };
struct Args {
    const float* in[28]; float* out; unsigned char* ws;
    double inv32[16]; double inv64[32];
    WJob jobs[NJOBS]; int tile_start[NJOBS + 2];
};

__device__ __forceinline__ unsigned cvt_pk_bf16(float lo, float hi) { unsigned r; asm volatile("v_cvt_pk_bf16_f32 %0, %1, %2" : "=v"(r) : "v"(lo), "v"(hi)); return r; }
__device__ __forceinline__ float bf_lo(unsigned w) { return __uint_as_float(w << 16); }
__device__ __forceinline__ float bf_hi(unsigned w) { return __uint_as_float(w & 0xffff0000u); }
__device__ __forceinline__ void unpack8(const u32x4 w, float (&x)[8]) { x[0] = bf_lo(w.x); x[1] = bf_hi(w.x); x[2] = bf_lo(w.y); x[3] = bf_hi(w.y); x[4] = bf_lo(w.z); x[5] = bf_hi(w.z); x[6] = bf_lo(w.w); x[7] = bf_hi(w.w); }
__device__ __forceinline__ u32x4 pack8(const float (&x)[8]) { u32x4 w; w.x = cvt_pk_bf16(x[0], x[1]); w.y = cvt_pk_bf16(x[2], x[3]); w.z = cvt_pk_bf16(x[4], x[5]); w.w = cvt_pk_bf16(x[6], x[7]); return w; }

__device__ __forceinline__ float xor32(float x, bool lower_half) { auto rr = __builtin_amdgcn_permlane32_swap(__float_as_uint(x), __float_as_uint(x), false, false); return __uint_as_float(lower_half ? rr[1] : rr[0]); }
#define XB_TMO      128
#define XB_XCNT(j)  (256  + 64 * (j))
#define XB_XSUB(j)  (1280 + 64 * (j))
#define XB_XGEN(j)  (2304 + 64 * (j))
#define XB_TOP      3328
#define XB_TOPGEN   3392
#define XCD_BAR_WORDS 3456
#define XB_SPIN_CAP (1u << 24)
__device__ __forceinline__ unsigned xb_ld(unsigned* p)              { return __hip_atomic_load(p, __ATOMIC_RELAXED, __HIP_MEMORY_SCOPE_AGENT); }
__device__ __forceinline__ unsigned xb_add(unsigned* p, unsigned v) { return __hip_atomic_fetch_add(p, v, __ATOMIC_RELAXED, __HIP_MEMORY_SCOPE_AGENT); }
__device__ __forceinline__ unsigned xb_xcc_id() { return (unsigned)__builtin_amdgcn_s_getreg((3 << 11) | 20) & 0xFu; }
#define XB_SPIN(cond, bar) do { unsigned _sp = 0; while (cond) { __builtin_amdgcn_s_sleep(1); \
    if ((++_sp & 255u) == 0u) { if (xb_ld(&(bar)[XB_TMO])) break; if (_sp > XB_SPIN_CAP) { atomicAdd(&(bar)[XB_TMO], 1u); break; } } } } while (0)
struct XcdBarrier { unsigned* bar; unsigned x; volatile LAS unsigned* st; };
__device__ __forceinline__ XcdBarrier xcd_barrier_post(unsigned* bar, volatile LAS unsigned* st) {
    XcdBarrier b; b.bar = bar; b.x = xb_xcc_id(); b.st = st;
    if (threadIdx.x == 0) (void)xb_add(&bar[XB_XCNT(b.x)], 1u);
    return b;
}
__device__ __forceinline__ void xcd_barrier_complete(unsigned* bar, unsigned x, unsigned& nloc, unsigned& nx) {
    const unsigned G = gridDim.x * gridDim.y * gridDim.z;
    unsigned sum, cnt, mine, sp = 0u;
    for (;;) {
        sum = 0u; cnt = 0u; mine = 0u;
#pragma unroll
        for (unsigned j = 0; j < 16; ++j) { const unsigned c = xb_ld(&bar[XB_XCNT(j)]); sum += c; cnt += (c > 0u) ? 1u : 0u; mine = (j == x) ? c : mine; }
        if (sum == G) break;
        __builtin_amdgcn_s_sleep(1);
        if ((++sp & 255u) == 0u) { if (xb_ld(&bar[XB_TMO])) break; if (sp > XB_SPIN_CAP) { atomicAdd(&bar[XB_TMO], 1u); break; } }
    }
    nloc = mine > 0u ? mine : 1u; nx = cnt > 0u ? cnt : 1u;
}
__device__ __forceinline__ void xcd_barrier(const XcdBarrier& b, int wv_) {
    asm volatile("s_waitcnt vmcnt(0)" ::: "memory");
    __syncthreads();
    if (wv_ == 0 && __builtin_amdgcn_mbcnt_hi(~0u, __builtin_amdgcn_mbcnt_lo(~0u, 0u)) == 0u) {
        unsigned* bar = b.bar;
        __builtin_amdgcn_s_waitcnt(0);
        unsigned nloc = b.st[0], nx = b.st[1];
        if (nloc == 0u) { xcd_barrier_complete(bar, b.x, nloc, nx); b.st[0] = nloc; b.st[1] = nx; }
        const unsigned old = xb_add(&bar[XB_XSUB(b.x)], 1u);
        const unsigned gen = old / nloc;
        if (old + 1u == (gen + 1u) * nloc) {
            __builtin_amdgcn_fence(__ATOMIC_RELEASE, "agent");
            asm volatile("s_waitcnt vmcnt(0)" ::: "memory");
            const unsigned og = xb_add(&bar[XB_TOP], 1u);
            const unsigned tg = og / nx;
            if (og + 1u == (tg + 1u) * nx) xb_add(&bar[XB_TOPGEN], 1u);
            else XB_SPIN(xb_ld(&bar[XB_TOPGEN]) == tg, bar);
            __builtin_amdgcn_fence(__ATOMIC_ACQUIRE, "agent");
            xb_add(&bar[XB_XGEN(b.x)], 1u);
            asm volatile("s_waitcnt vmcnt(0)" ::: "memory");
        } else {
            XB_SPIN(xb_ld(&bar[XB_XGEN(b.x)]) == gen, bar);
            __builtin_amdgcn_fence(__ATOMIC_ACQUIRE, "agent");
            asm volatile("s_waitcnt vmcnt(0)" ::: "memory");
        }
    }
    __syncthreads();
}

namespace pg8 {
constexpr int BM = 256, BK = 64, HALF = 128, HTB = HALF * BK * 2, STAGE_BYTES = 8 * HTB, NXCD = 8, WGM = 8;
__device__ __forceinline__ int lds_byte(int r, int c) { const int st = (r >> 4) * 2 + (c >> 5), rr = r & 15, cc = c & 31, ob = rr * 64 + cc * 2; return st * 1024 + (ob ^ (((ob >> 9) & 1) << 5)); }
__device__ __forceinline__ void stage_rc(int b, int& R, int& C) { const int st = b / 1024, sb = b % 1024, swz = sb ^ (((sb >> 9) & 1) << 5); R = (st >> 1) * 16 + swz / 64; C = (st & 1) * 32 + (swz % 64) / 2; }
__device__ __forceinline__ int perm32(int rho) { const int n = rho >> 4, i = rho & 15; return 8 * (i >> 2) + 4 * n + (i & 3); }
struct Unit { int pm, pn; };
struct Gemm { const bf16_t* A; const bf16_t* Bt; int M, N, K; };
struct StaticOrder {
    int nM, nN, nwg, G, c;
    __device__ void init(int M, int N, int G_, int c_) { nM = M / BM; nN = N / BM; nwg = nM * nN; G = G_; c = c_; }
    __device__ bool next(int i, Unit& u) const {
        const long L = (long)i * G + c; if (L >= nwg) return false;
        int wgid = (int)L; { const int q = nwg / NXCD, r = nwg % NXCD, xcd = wgid % NXCD, off = wgid / NXCD; wgid = (xcd < r ? xcd * (q + 1) : r * (q + 1) + (xcd - r) * q) + off; }
        const int nig = WGM * nN, gid = wgid / nig, fm = gid * WGM, gsz = (nM - fm) < WGM ? (nM - fm) : WGM;
        u.pm = fm + ((wgid % nig) % gsz); u.pn = (wgid % nig) / gsz; return true;
    }
    __device__ __forceinline__ void a_ready(const Unit&) const {}
    __device__ __forceinline__ void done(const Unit&) const {}
};

struct EpiScaleBf16 {
    static constexpr bool PERM = true;
    bf16_t* O; int ldc; int split_cols; size_t split_stride; const float* ss; float inv_dim; float* sso0; float* sso1;
    __device__ __forceinline__ void operator()(const f32x4 (&acc)[2][2][4][2], const Unit& u, int wr, int wc, int fr, int fq) const {
        const int row0 = u.pm * BM + wr * 64 + fr; int colt = u.pn * BM; bf16_t* base = O;
        if (split_cols) { const int t = colt / split_cols; base += (size_t)t * split_stride; colt -= t * split_cols; }
        const int col0 = colt + wc * 32 + 8 * fq;
        float* sso = sso0 ? (u.pn < 2 ? sso0 : (u.pn < 4 ? sso1 : nullptr)) : nullptr;
        float rsv[2][4];
#pragma unroll
        for (int ai = 0; ai < 2; ++ai)
#pragma unroll
            for (int m = 0; m < 4; ++m) rsv[ai][m] = ss ? ss[row0 + ai * HALF + m * 16] : 0.f;
#pragma unroll
        for (int ai = 0; ai < 2; ++ai)
#pragma unroll
            for (int m = 0; m < 4; ++m) {
                const int row = row0 + ai * HALF + m * 16;
                const float rs = ss ? rsqrtf(rsv[ai][m] * inv_dim + EPS) : 1.0f;
                float part = 0.f;
                bf16_t* rowp = base + (size_t)row * ldc + col0;
#pragma unroll
                for (int bj = 0; bj < 2; ++bj) {
                    const f32x4 v0 = acc[ai][bj][m][0] * rs, v1 = acc[ai][bj][m][1] * rs;
                    part += (v0[0] * v0[0] + v0[1] * v0[1]) + (v0[2] * v0[2] + v0[3] * v0[3]) + (v1[0] * v1[0] + v1[1] * v1[1]) + (v1[2] * v1[2] + v1[3] * v1[3]);
                    u32x4 w; w.x = cvt_pk_bf16(v0[0], v0[1]); w.y = cvt_pk_bf16(v0[2], v0[3]); w.z = cvt_pk_bf16(v1[0], v1[1]); w.w = cvt_pk_bf16(v1[2], v1[3]);
                    *(u32x4*)(rowp + bj * HALF) = w;
                }
                if (sso) { part += __shfl_xor(part, 16); part += __shfl_xor(part, 32); if (fq == 0) unsafeAtomicAdd(sso + row, part); }
            }
    }
};
struct EpiQKNorm {
    static constexpr bool PERM = true, TWICE = false;
    bf16_t* O; int ldc; const float* ss; int nq_tiles, nqk_tiles; const float* gq; const float* gk; const f32x2* rope; LAS float* xch;
    __device__ __forceinline__ void operator()(const f32x4 (&acc)[2][2][4][2], const Unit& u, int wr, int wc, int fr, int fq) const {
        const int row0 = u.pm * BM + wr * 64 + fr, col0 = u.pn * BM + wc * 32 + 8 * fq;
        float rsv[2][4];
#pragma unroll
        for (int ai = 0; ai < 2; ++ai)
#pragma unroll
            for (int m = 0; m < 4; ++m) rsv[ai][m] = rsqrtf(ss[row0 + ai * HALF + m * 16] * (1.0f / DM) + EPS);
        if (u.pn >= nqk_tiles) {
#pragma unroll
            for (int ai = 0; ai < 2; ++ai)
#pragma unroll
                for (int m = 0; m < 4; ++m) {
                    const float rs = rsv[ai][m]; bf16_t* rowp = O + (size_t)(row0 + ai * HALF + m * 16) * ldc + col0;
#pragma unroll
                    for (int bj = 0; bj < 2; ++bj) {
                        const f32x4 v0 = acc[ai][bj][m][0] * rs, v1 = acc[ai][bj][m][1] * rs;
                        u32x4 w; w.x = cvt_pk_bf16(v0[0], v0[1]); w.y = cvt_pk_bf16(v0[2], v0[3]); w.z = cvt_pk_bf16(v1[0], v1[1]); w.w = cvt_pk_bf16(v1[2], v1[3]);
                        *(u32x4*)(rowp + bj * HALF) = w;
                    }
                }
            return;
        }
        const float* g = (u.pn < nq_tiles ? gq : gk) + wc * 32 + 8 * fq;
        float gv[8];
#pragma unroll
        for (int j = 0; j < 8; ++j) gv[j] = g[j];
#pragma unroll
        for (int ai = 0; ai < 2; ++ai)
#pragma unroll
            for (int m = 0; m < 4; ++m) {
                const float rs = rsv[ai][m];
#pragma unroll
                for (int bj = 0; bj < 2; ++bj) {
                    const f32x4 v0 = acc[ai][bj][m][0] * rs, v1 = acc[ai][bj][m][1] * rs;
                    float part = (v0[0] * v0[0] + v0[1] * v0[1]) + (v0[2] * v0[2] + v0[3] * v0[3]) + (v1[0] * v1[0] + v1[1] * v1[1]) + (v1[2] * v1[2] + v1[3] * v1[3]);
                    part += __shfl_xor(part, 16); part += xor32(part, fq < 2);
                    if (fq == 0) xch[((ai * HALF + wr * 64 + m * 16 + fr) * 2 + bj) * 4 + wc] = part;
                }
            }
        asm volatile("s_waitcnt lgkmcnt(0)" ::: "memory"); __builtin_amdgcn_s_barrier(); asm volatile("" ::: "memory");
        f32x2 csb[2][8];
#define QKN_LOADCS(g_, slot_) do { if (wc == 0) { const size_t rr_ = (size_t)(u.pm * BM + ((g_) >> 2) * HALF + wr * 64 + ((g_) & 3) * 16 + fr) * 16 + (fq & 1) * 8; \
        _Pragma("unroll") for (int j_ = 0; j_ < 8; ++j_) csb[slot_][j_] = rope[rr_ + j_]; } } while (0)
        QKN_LOADCS(0, 0);
#pragma unroll
        for (int g = 0; g < 8; ++g) {
            {
                const int ai = g >> 2, m = g & 3;
                if (g + 1 < 8) { if ((g & 1) == 0) QKN_LOADCS(g + 1, 1); else QKN_LOADCS(g + 1, 0); }
                asm volatile("" ::: "memory");
                const f32x2 (&cs)[8] = csb[g & 1];
                const int rl = ai * HALF + wr * 64 + m * 16 + fr, row = u.pm * BM + rl; const float rs = rsv[ai][m];
#pragma unroll
                for (int bj = 0; bj < 2; ++bj) {
                    const f32x4 t4 = *(const LAS f32x4*)(xch + (rl * 2 + bj) * 4);
                    const float sc = rs * rsqrtf(((t4[0] + t4[1]) + (t4[2] + t4[3])) * (1.0f / 128.0f) + EPS);
                    float y[8];
#pragma unroll
                    for (int j = 0; j < 4; ++j) { y[j] = acc[ai][bj][m][0][j] * sc * gv[j]; y[4 + j] = acc[ai][bj][m][1][j] * sc * gv[4 + j]; }
                    if (wc == 0) {
#pragma unroll
                        for (int j = 0; j < 8; ++j) { const float yp = xor32(y[j], fq < 2); y[j] = (fq < 2) ? (y[j] * cs[j].x - yp * cs[j].y) : (y[j] * cs[j].x + yp * cs[j].y); }
                    }
                    *(u32x4*)(O + (size_t)row * ldc + col0 + bj * HALF) = pack8(y);
                }
                asm volatile("" ::: "memory");
            }
        }
#undef QKN_LOADCS
    }
};
struct EpiSwiglu {
    static constexpr bool PERM = true;
    bf16_t* O; const float* ss;
    __device__ __forceinline__ void operator()(const f32x4 (&acc)[2][2][4][2], const Unit& u, int wr, int wc, int fr, int fq) const {
        const int row0 = u.pm * BM + wr * 64 + fr, col0 = u.pn * HALF + wc * 32 + 8 * fq;
        float rsv[2][4];
#pragma unroll
        for (int ai = 0; ai < 2; ++ai)
#pragma unroll
            for (int m = 0; m < 4; ++m) rsv[ai][m] = ss[row0 + ai * HALF + m * 16];
#pragma unroll
        for (int ai = 0; ai < 2; ++ai)
#pragma unroll
            for (int m = 0; m < 4; ++m) {
                const int row = row0 + ai * HALF + m * 16;
                const float rs = rsqrtf(rsv[ai][m] * (1.0f / DM) + EPS);
                float o[8];
#pragma unroll
                for (int n = 0; n < 2; ++n)
#pragma unroll
                    for (int j = 0; j < 4; ++j) {
                        const float g = acc[ai][0][m][n][j] * rs, uu = acc[ai][1][m][n][j] * rs;
                        o[n * 4 + j] = g * __builtin_amdgcn_rcpf(1.0f + __expf(-g)) * uu;
                    }
                *(u32x4*)(O + (size_t)row * FF + col0) = pack8(o);
            }
    }
};
template <bool PLE_> struct EpiResT {
    static constexpr bool PERM = false;
    const float* Hin; float* H; bf16_t* HB; const bf16_t* PP; const float* ss; float* sso;
    __device__ __forceinline__ void operator()(const f32x4 (&acc)[2][2][4][2], const Unit& u, int wr, int wc, int fr, int fq) const {
        const int row0 = u.pm * BM + wr * 64 + fr, col0 = u.pn * BM + wc * 32 + 4 * fq;
        float rsv[8];
        if constexpr (PLE_) {
#pragma unroll
            for (int g = 0; g < 8; ++g) rsv[g] = ss[row0 + (g >> 2) * HALF + (g & 3) * 16];
        }
        f32x4 hb_[2][4]; u32x2 pb_[2][4];
#define EPI_LOAD(g, slot) do { const size_t off_ = (size_t)(row0 + ((g) >> 2) * HALF + ((g) & 3) * 16) * DM + col0; \
        _Pragma("unroll") for (int q_ = 0; q_ < 4; ++q_) { const size_t o2_ = off_ + (q_ >> 1) * HALF + (q_ & 1) * 16; hb_[slot][q_] = *(const f32x4*)(Hin + o2_); if constexpr (PLE_) pb_[slot][q_] = *(const u32x2*)(PP + o2_); } } while (0)
        EPI_LOAD(0, 0);
#pragma unroll
        for (int g = 0; g < 8; ++g) {
            const int ai = g >> 2, m = g & 3, slot = g & 1;
            if (g + 1 < 8) { if (slot == 0) EPI_LOAD(g + 1, 1); else EPI_LOAD(g + 1, 0); }
            asm volatile("" ::: "memory");
            const int row = row0 + ai * HALF + m * 16; const size_t off = (size_t)row * DM + col0; float part = 0.f;
            float rs = 1.f; if constexpr (PLE_) rs = rsqrtf(rsv[g] * (1.0f / DM) + EPS);
#pragma unroll
            for (int q = 0; q < 4; ++q) {
                const int bj = q >> 1, n = q & 1; const size_t o2 = off + bj * HALF + n * 16;
                f32x4 hv = hb_[slot][q];
                if constexpr (PLE_) {
                    const u32x2 pw = pb_[slot][q]; const f32x4 pv = {bf_lo(pw.x), bf_hi(pw.x), bf_lo(pw.y), bf_hi(pw.y)};
#pragma unroll
                    for (int j = 0; j < 4; ++j) { const float a = acc[ai][bj][m][n][j] * rs; hv[j] += __builtin_amdgcn_rcpf(1.0f + __expf(-a)) * pv[j]; }
                } else hv += acc[ai][bj][m][n];
                *(f32x4*)(H + o2) = hv;
                u32x2 w; w.x = cvt_pk_bf16(hv[0], hv[1]); w.y = cvt_pk_bf16(hv[2], hv[3]); *(u32x2*)(HB + o2) = w;
                part += (hv[0] * hv[0] + hv[1] * hv[1]) + (hv[2] * hv[2] + hv[3] * hv[3]);
            }
            part += __shfl_xor(part, 16); part += __shfl_xor(part, 32); if (fq == 0) unsafeAtomicAdd(sso + row, part);
            asm volatile("" ::: "memory");
        }
#undef EPI_LOAD
    }
};
typedef EpiResT<false> EpiResid;
typedef EpiResT<true> EpiPle;

template <class Epi, class Sched>
__device__ __forceinline__ void gemm_phase(LAS unsigned char* lds, const Gemm g, const Sched& S, const Epi& E, int wv_) {
    int tid; { unsigned z_ = 0u; asm volatile("" : "+v"(z_)); tid = wv_ * 64 + (int)__builtin_amdgcn_mbcnt_hi(~0u, __builtin_amdgcn_mbcnt_lo(~0u, z_)); asm volatile("" : "+v"(tid)); }
    const int wid = __builtin_amdgcn_readfirstlane(tid >> 6), lane = tid & 63, wr = wid >> 2, wc = wid & 3, fr = lane & 15, fq = lane >> 4;
    const int K = g.K, nt = K / BK;
    unsigned voffA[2], voffB[2];
#pragma unroll
    for (int i = 0; i < 2; ++i) { int R, C; stage_rc(tid * 16 + i * 8192, R, C); const int Rb = Epi::PERM ? ((R & ~31) + perm32(R & 31)) : R;
        voffA[i] = (unsigned)(R * K + C) * 2u; voffB[i] = (unsigned)(Rb * K + C) * 2u; }
    const size_t kstep = (size_t)(BK * 2);
    const size_t hstep = (size_t)HALF * K * 2;
    const size_t tstep = 2 * hstep;
    const unsigned ldsw = (unsigned)wid * 1024u;
    const int aoff = lds_byte(wr * 64 + fr, fq * 8), boff = lds_byte(wc * 32 + fr, fq * 8);
#define PG8_SA(b, h) (((b) * 2 + (h)) * HTB)
#define PG8_SB(b, h) ((4 + (b) * 2 + (h)) * HTB)
#define PG8_STAGE(bufoff, gbase, voff) do { _Pragma("unroll") for (int _i = 0; _i < 2; ++_i) \
        __builtin_amdgcn_global_load_lds((const unsigned*)((const char*)(gbase) + (voff)[_i]), (LAS unsigned*)(lds + (bufoff) + ldsw + _i * 8192), 16, 0, 0); } while (0)
#define PG8_LDA(dst, b, h) do { _Pragma("unroll") for (int m = 0; m < 4; ++m) _Pragma("unroll") for (int k = 0; k < 2; ++k) dst[m][k] = *(const LAS bf16x8*)(lds + PG8_SA(b, h) + aoff + m * 2048 + k * 1024); } while (0)
#define PG8_LDB(dst, b, h) do { _Pragma("unroll") for (int n = 0; n < 2; ++n) _Pragma("unroll") for (int k = 0; k < 2; ++k) dst[n][k] = *(const LAS bf16x8*)(lds + PG8_SB(b, h) + boff + n * 2048 + k * 1024); } while (0)
#define PG8_MMA(ai, bj, At, Bt) do { __builtin_amdgcn_s_setprio(1); _Pragma("unroll") for (int m = 0; m < 4; ++m) _Pragma("unroll") for (int n = 0; n < 2; ++n) _Pragma("unroll") for (int k = 0; k < 2; ++k) \
        acc[ai][bj][m][n] = __builtin_amdgcn_mfma_f32_16x16x32_bf16(Bt[n][k], At[m][k], acc[ai][bj][m][n], 0, 0, 0); __builtin_amdgcn_s_setprio(0); } while (0)
#define PG8_WAIT_V(n) asm volatile("s_waitcnt vmcnt(" #n ")" ::: "memory")
#define PG8_WAIT_L(n) asm volatile("s_waitcnt lgkmcnt(" #n ")" ::: "memory")
#define PG8_BAR __builtin_amdgcn_s_barrier()
#define PG8_SCHED __builtin_amdgcn_sched_barrier(0)
    Unit cur, nxt; int ui = 0;
    if (!S.next(0, cur)) return;
    f32x4 acc[2][2][4][2];
#pragma unroll
    for (int a = 0; a < 2; ++a)
#pragma unroll
        for (int b = 0; b < 2; ++b)
#pragma unroll
            for (int m = 0; m < 4; ++m)
#pragma unroll
                for (int n = 0; n < 2; ++n) acc[a][b][m][n] = (f32x4){0.f, 0.f, 0.f, 0.f};
    bf16x8 At[4][2], B0[2][2], B1[2][2];
    const char* cA = (const char*)g.A + (size_t)cur.pm * tstep; const char* cB = (const char*)g.Bt + (size_t)cur.pn * tstep;
    S.a_ready(cur);
    PG8_STAGE(PG8_SB(0, 0), cB, voffB); PG8_STAGE(PG8_SA(0, 0), cA, voffA); PG8_STAGE(PG8_SB(0, 1), cB + hstep, voffB); PG8_STAGE(PG8_SA(0, 1), cA + hstep, voffA);
    if (wr == 1) PG8_BAR;
    PG8_WAIT_V(4); PG8_BAR;
    PG8_STAGE(PG8_SB(1, 0), cB + kstep, voffB); PG8_STAGE(PG8_SA(1, 0), cA + kstep, voffA); PG8_STAGE(PG8_SB(1, 1), cB + hstep + kstep, voffB);
    PG8_WAIT_V(6); PG8_BAR;
    for (;;) {
        const bool has_next = S.next(ui + 1, nxt);
        const char* nA = has_next ? (const char*)g.A + (size_t)nxt.pm * tstep : cA; const char* nB = has_next ? (const char*)g.Bt + (size_t)nxt.pn * tstep : cB;
        for (int t = 0; t < nt; t += 2) {
            const bool last = (t == nt - 2);
            const char* a1 = cA + (size_t)(t + 1) * kstep;
            const char* a2 = last ? nA : cA + (size_t)(t + 2) * kstep; const char* b2 = last ? nB : cB + (size_t)(t + 2) * kstep;
            const char* a3 = a2 + kstep; const char* b3 = b2 + kstep;
            if (last && has_next) S.a_ready(nxt);
            PG8_LDB(B0, 0, 0); PG8_SCHED; PG8_LDA(At, 0, 0); PG8_STAGE(PG8_SA(1, 1), a1 + hstep, voffA);
            PG8_WAIT_L(8); PG8_BAR; PG8_WAIT_L(0); PG8_MMA(0, 0, At, B0); PG8_BAR; PG8_SCHED;
            PG8_LDB(B1, 0, 1); PG8_STAGE(PG8_SB(0, 0), b2, voffB);
            PG8_BAR; PG8_WAIT_L(0); PG8_MMA(0, 1, At, B1); PG8_BAR;
            PG8_LDA(At, 0, 1); PG8_STAGE(PG8_SA(0, 0), a2, voffA);
            PG8_BAR; PG8_WAIT_L(0); PG8_MMA(1, 0, At, B0); PG8_BAR; PG8_SCHED;
            PG8_STAGE(PG8_SB(0, 1), b2 + hstep, voffB);
            PG8_WAIT_V(6); PG8_BAR; PG8_MMA(1, 1, At, B1); PG8_BAR;
            PG8_LDB(B0, 1, 0); PG8_SCHED; PG8_LDA(At, 1, 0); PG8_STAGE(PG8_SA(0, 1), a2 + hstep, voffA);
            PG8_WAIT_L(8); PG8_BAR; PG8_WAIT_L(0); PG8_MMA(0, 0, At, B0); PG8_BAR; PG8_SCHED;
            PG8_LDB(B1, 1, 1); PG8_STAGE(PG8_SB(1, 0), b3, voffB);
            PG8_BAR; PG8_WAIT_L(0); PG8_MMA(0, 1, At, B1); PG8_BAR;
            PG8_LDA(At, 1, 1); PG8_STAGE(PG8_SA(1, 0), a3, voffA);
            PG8_BAR; PG8_WAIT_L(0); PG8_MMA(1, 0, At, B0); PG8_BAR; PG8_SCHED;
            PG8_STAGE(PG8_SB(1, 1), b3 + hstep, voffB);
            PG8_WAIT_V(6); PG8_BAR; PG8_MMA(1, 1, At, B1); PG8_BAR;
        }
        E(acc, cur, wr, wc, fr, fq); S.done(cur);
        if (!has_next) break;
#pragma unroll
        for (int a = 0; a < 2; ++a)
#pragma unroll
            for (int b = 0; b < 2; ++b)
#pragma unroll
                for (int m = 0; m < 4; ++m)
#pragma unroll
                    for (int n = 0; n < 2; ++n) acc[a][b][m][n] = (f32x4){0.f, 0.f, 0.f, 0.f};
        cur = nxt; cA = nA; cB = nB; ++ui;
    }
    PG8_WAIT_V(0);
    if (wr == 0) PG8_BAR;
    PG8_BAR;
#undef PG8_SA
#undef PG8_SB
#undef PG8_STAGE
#undef PG8_LDA
#undef PG8_LDB
#undef PG8_MMA
#undef PG8_WAIT_V
#undef PG8_WAIT_L
#undef PG8_BAR
#undef PG8_SCHED
}
}

template <class Epi>
__device__ __forceinline__ void run_gemm(LAS unsigned char* lds, const bf16_t* A, const bf16_t* Bt, int N, int K, const Epi& E, int wv_) {
    int G_ = (int)gridDim.x, c_ = (int)blockIdx.x; asm volatile("" : "+s"(G_), "+s"(c_));
    pg8::Gemm g{A, Bt, SEQ, N, K}; pg8::StaticOrder S; S.init(SEQ, N, G_, c_);
#ifndef NO_GEMM
    pg8::gemm_phase<Epi, pg8::StaticOrder>(lds, g, S, E, wv_);
#endif
}

namespace att {
constexpr int KVBLK = 64;
constexpr int SHM_V = KVBLK * 128 * 2;
#define SBAR() __builtin_amdgcn_sched_barrier(0)
__device__ __forceinline__ int crow(int r, int hi) { return (r & 3) + 8 * (r >> 2) + 4 * hi; }
template <int DQ> __device__ __forceinline__ int kswz(int row, int colB) { return row * (DQ * 2) + (colB ^ ((row & 7) << 4)); }

template <int DQ>
__device__ __forceinline__ void partialSM(f32x16& p0, f32x16& p1, float& m_reg, float& mn, float& alpha) {
    constexpr float SCALE = DQ == 128 ? 0.088388347648318440f : 0.072168783648703220f;
    constexpr float THR = 8.f;
    constexpr float C = SCALE * 1.4426950408889634f;
    float pmax = p0[0];
#pragma unroll
    for (int r = 1; r < 16; ++r) pmax = fmaxf(pmax, p0[r]);
#pragma unroll
    for (int r = 0; r < 16; ++r) pmax = fmaxf(pmax, p1[r]);
    { auto rr = __builtin_amdgcn_permlane32_swap(__float_as_uint(pmax), __float_as_uint(pmax), false, false);
      pmax = fmaxf(__uint_as_float(rr[0]), __uint_as_float(rr[1])); }
    if (__builtin_expect(__all(pmax - m_reg <= THR / SCALE), 1)) { mn = m_reg; alpha = 1.f; }
    else { mn = fmaxf(m_reg, pmax); alpha = __builtin_amdgcn_exp2f((m_reg - mn) * C); m_reg = mn; }
    const float mnC = -mn * C;
#pragma unroll
    for (int r = 0; r < 16; ++r) p0[r] = fmaf(p0[r], C, mnC);
#pragma unroll
    for (int r = 0; r < 16; ++r) p1[r] = fmaf(p1[r], C, mnC);
#pragma unroll
    for (int r = 0; r < 16; ++r) p0[r] = __builtin_amdgcn_exp2f(p0[r]);
}
__device__ __forceinline__ void finishSM(f32x16& p0, f32x16& p1, float alpha, float& l_reg, bf16x8& pa0, bf16x8& pa1, bf16x8& pa2, bf16x8& pa3) {
#pragma unroll
    for (int r = 0; r < 16; ++r) p1[r] = __builtin_amdgcn_exp2f(p1[r]);
    float ps = 0;
#pragma unroll
    for (int r = 0; r < 16; ++r) ps += p0[r];
#pragma unroll
    for (int r = 0; r < 16; ++r) ps += p1[r];
    { auto rr = __builtin_amdgcn_permlane32_swap(__float_as_uint(ps), __float_as_uint(ps), false, false);
      ps = __uint_as_float(rr[0]) + __uint_as_float(rr[1]); }
    l_reg = l_reg * alpha + ps;
#define PK4(P, BASE, OUT) do { unsigned a0 = cvt_pk_bf16(P[BASE + 0], P[BASE + 1]), a1 = cvt_pk_bf16(P[BASE + 2], P[BASE + 3]);   \
    unsigned b0 = cvt_pk_bf16(P[BASE + 4], P[BASE + 5]), b1 = cvt_pk_bf16(P[BASE + 6], P[BASE + 7]);                              \
    auto r0 = __builtin_amdgcn_permlane32_swap(a0, b0, false, false); auto r1 = __builtin_amdgcn_permlane32_swap(a1, b1, false, false); \
    u32x4 w = {r0[0], r1[0], r0[1], r1[1]}; OUT = *reinterpret_cast<bf16x8*>(&w); } while (0)
    PK4(p0, 0, pa0); PK4(p0, 8, pa1); PK4(p1, 0, pa2); PK4(p1, 8, pa3);
#undef PK4
}
template <int DQ, int NQR>
__device__ __forceinline__ void qkt(f32x16& p0, f32x16& p1, const char* Ks, const bf16x8* qr, const char* Qs, int r32, int hi) {
    p0 = f32x16{}; p1 = f32x16{};
#pragma unroll
    for (int d0 = 0; d0 < DQ / 16; ++d0) { const int cb = (d0 * 16 + hi * 8) * 2;
        bf16x8 b0 = *reinterpret_cast<const bf16x8*>(Ks + kswz<DQ>(r32, cb));
        bf16x8 b1 = *reinterpret_cast<const bf16x8*>(Ks + kswz<DQ>(32 + r32, cb));
        bf16x8 q;
        if (d0 < NQR) q = qr[d0 < NQR ? d0 : 0]; else q = *reinterpret_cast<const bf16x8*>(Qs + (d0 - NQR) * 1024);
        p0 = __builtin_amdgcn_mfma_f32_32x32x16_bf16(b0, q, p0, 0, 0, 0);
        p1 = __builtin_amdgcn_mfma_f32_32x32x16_bf16(b1, q, p1, 0, 0, 0); }
}
__device__ __forceinline__ void band_mask(f32x16& p0, f32x16& p1, int kb, int qp, int hw, int Lc, int hi) {
    const float NINF = -__builtin_inff();
#pragma unroll
    for (int r = 0; r < 16; ++r) {
        const int kp0 = kb + crow(r, hi), kp1 = kp0 + 32;
        const bool ok0 = ((unsigned)(kp0 - qp + hw) <= (unsigned)(2 * hw)) && ((unsigned)kp0 < (unsigned)Lc);
        const bool ok1 = ((unsigned)(kp1 - qp + hw) <= (unsigned)(2 * hw)) && ((unsigned)kp1 < (unsigned)Lc);
        p0[r] = ok0 ? p0[r] : NINF; p1[r] = ok1 ? p1[r] : NINF;
    }
}
__device__ __forceinline__ int v_st(int k, int c) { const int kk = (k & ~0xC) | ((k & 4) << 1) | ((k & 8) >> 1); return ((kk >> 3) * 4 + (c >> 5)) * 512 + ((kk & 7) * 32 + (c & 31)) * 2; }
__device__ __forceinline__ int v_rd_base(int lane) { return ((lane & 3) << 3) | (((lane >> 2) & 3) << 6) | (((lane >> 4) & 1) << 5) | (((lane >> 5) & 1) << 8); }
constexpr int v_rd_off(int d0, int ks, int half) { return d0 * 512 + ks * 4096 + half * 2048; }
template <int OFF> __device__ __forceinline__ s16x4 tr_read(int vb) {
    s16x4 r; asm volatile("ds_read_b64_tr_b16 %0, %1 offset:%2" : "=&v"(r) : "v"(vb), "i"(OFF) : "memory"); return r;
}
template <int D0> __device__ __forceinline__ void pv_one(f32x16& od, int vb, bf16x8 pa0, bf16x8 pa1, bf16x8 pa2, bf16x8 pa3) {
    const s16x4 l0 = tr_read<v_rd_off(D0, 0, 0)>(vb), h0 = tr_read<v_rd_off(D0, 0, 1)>(vb), l1 = tr_read<v_rd_off(D0, 1, 0)>(vb), h1 = tr_read<v_rd_off(D0, 1, 1)>(vb);
    const s16x4 l2 = tr_read<v_rd_off(D0, 2, 0)>(vb), h2 = tr_read<v_rd_off(D0, 2, 1)>(vb), l3 = tr_read<v_rd_off(D0, 3, 0)>(vb), h3 = tr_read<v_rd_off(D0, 3, 1)>(vb);
    asm volatile("s_waitcnt lgkmcnt(0)" ::: "memory"); SBAR();
#define PK(L, H) (bf16x8){L[0], L[1], L[2], L[3], H[0], H[1], H[2], H[3]}
    od = __builtin_amdgcn_mfma_f32_32x32x16_bf16(pa0, PK(l0, h0), od, 0, 0, 0);
    od = __builtin_amdgcn_mfma_f32_32x32x16_bf16(pa1, PK(l1, h1), od, 0, 0, 0);
    od = __builtin_amdgcn_mfma_f32_32x32x16_bf16(pa2, PK(l2, h2), od, 0, 0, 0);
    od = __builtin_amdgcn_mfma_f32_32x32x16_bf16(pa3, PK(l3, h3), od, 0, 0, 0);
#undef PK
}
__device__ __forceinline__ void pv_d0(f32x16* o, int vb, bf16x8 pa0, bf16x8 pa1, bf16x8 pa2, bf16x8 pa3) {
    pv_one<0>(o[0], vb, pa0, pa1, pa2, pa3); pv_one<1>(o[1], vb, pa0, pa1, pa2, pa3); pv_one<2>(o[2], vb, pa0, pa1, pa2, pa3); pv_one<3>(o[3], vb, pa0, pa1, pa2, pa3);
}

template <int DQ, int MODE, int SDEPTH>
__device__ __forceinline__ void attn_body(const bf16_t* __restrict__ Qb, long ldq, const bf16_t* __restrict__ Kh, long ldk, const bf16_t* __restrict__ Vh, long ldv,
                                          bf16_t* __restrict__ Ob, long ldo, float* __restrict__ lse_out, long ldl,
                                          int q0, int kt0, int NT, int Lc, int hw, float sink, char* lds, int wv_) {
    constexpr int SHM_K = KVBLK * DQ * 2;
    constexpr float SCALE = DQ == 128 ? 0.088388347648318440f : 0.072168783648703220f;
    constexpr float C = SCALE * 1.4426950408889634f;
    int tid; { unsigned z_ = 0u; asm volatile("" : "+v"(z_)); tid = wv_ * 64 + (int)__builtin_amdgcn_mbcnt_hi(~0u, __builtin_amdgcn_mbcnt_lo(~0u, z_)); asm volatile("" : "+v"(tid)); }
    const int wid = tid >> 6, lane = tid & 63, r32 = lane & 31, hi = lane >> 5;
    char* V_lds = lds; char* K_lds = lds + 2 * SHM_V;
    float* ws = (float*)(lds + 2 * SHM_V + 2 * SHM_K) + wid * 64; float* li_l = ws; float* al_l = ws + 32;
    constexpr int NQR = (DQ == 192) ? 8 : (MODE == 0 ? 8 : 4);
    float m_reg = -1e30f, l_reg = 0; f32x16 o[4] = {}; bf16x8 qr[NQR];
    const int qp = q0 + wid * 32 + r32;
    const bf16_t* Qw = Qb + (long)qp * ldq + hi * 8;
    char* Qs = lds + 2 * SHM_V + 2 * SHM_K + 2048 + wid * 4096 + lane * 16;
#pragma unroll
    for (int d0 = 0; d0 < NQR; ++d0) qr[d0] = *reinterpret_cast<const bf16x8*>(Qw + d0 * 16);
    bf16x8 qpark[DQ / 16 - NQR];
#pragma unroll
    for (int d0 = NQR; d0 < DQ / 16; ++d0) qpark[d0 - NQR] = *reinterpret_cast<const bf16x8*>(Qw + d0 * 16);
    const int sr = tid >> 4, sc = (tid & 15) * 8, vst0 = v_st(sr, sc), vst1 = v_st(32 + sr, sc);
    const int sr2 = tid >> 3, sc2 = 128 + (tid & 7) * 8;
    const int vb0 = (int)(uintptr_t)V_lds + v_rd_base(lane);
    struct { bf16x8 vs0, vs1, ks0, ks1, ks2; } sr_[SDEPTH];
#define CLAMPR(x) ((x) < 0 ? 0 : ((x) >= Lc ? Lc - 1 : (x)))
#define SLOAD(i, kb) do { const long ra = CLAMPR((kb) + sr), rb = CLAMPR((kb) + 32 + sr); \
    sr_[i].vs0 = *reinterpret_cast<const bf16x8*>(Vh + ra * ldv + sc); sr_[i].vs1 = *reinterpret_cast<const bf16x8*>(Vh + rb * ldv + sc); \
    sr_[i].ks0 = *reinterpret_cast<const bf16x8*>(Kh + ra * ldk + sc); sr_[i].ks1 = *reinterpret_cast<const bf16x8*>(Kh + rb * ldk + sc); \
    if constexpr (DQ == 192) { const long rc = CLAMPR((kb) + sr2); sr_[i].ks2 = *reinterpret_cast<const bf16x8*>(Kh + rc * ldk + sc2); } } while (0)
#define SWRITE(b, i) do { *(bf16x8*)(V_lds + (b) * SHM_V + vst0) = sr_[i].vs0; *(bf16x8*)(V_lds + (b) * SHM_V + vst1) = sr_[i].vs1; \
    *(bf16x8*)(K_lds + (b) * SHM_K + kswz<DQ>(sr, sc * 2)) = sr_[i].ks0; *(bf16x8*)(K_lds + (b) * SHM_K + kswz<DQ>(32 + sr, sc * 2)) = sr_[i].ks1; \
    if constexpr (DQ == 192) { *(bf16x8*)(K_lds + (b) * SHM_K + kswz<DQ>(sr2, sc2 * 2)) = sr_[i].ks2; } } while (0)
#define SWAIT() do { if constexpr (SDEPTH == 2) { if constexpr (DQ == 192) asm volatile("s_waitcnt vmcnt(5)" ::: "memory"); else asm volatile("s_waitcnt vmcnt(4)" ::: "memory"); } else asm volatile("s_waitcnt vmcnt(0)" ::: "memory"); } while (0)
#define RESC(a) do { if (__any((a) < 1.f)) { if (hi == 0) al_l[r32] = (a); asm volatile("s_waitcnt lgkmcnt(0)" ::: "memory"); \
    _Pragma("unroll") for (int d = 0; d < 4; ++d) _Pragma("unroll") for (int r = 0; r < 16; ++r) o[d][r] *= al_l[crow(r, hi)]; } } while (0)
#define MASK(P0, P1, j) do { if constexpr (MODE != 0) band_mask(P0, P1, kt0 + (j) * KVBLK, qp, hw, Lc, hi); } while (0)
    f32x16 pA0, pA1, pB0, pB1; float mnA, mnB, alA = 1.f, alB = 1.f;
    constexpr int SE = 0, SO = SDEPTH - 1;
    const int wq = __builtin_amdgcn_readfirstlane(wid) * 32;
    const int jlo = MODE == 0 ? 0 : (wq >= 64 ? (wq - 63 + 63) / 64 : 0), jhi = MODE == 0 ? 0x7fffffff : (wq + 31 + 2 * hw) / 64;
#define REL(j) (MODE == 0 ? true : ((j) >= jlo && (j) <= jhi))
    bool relA = REL(0), relB;
    SLOAD(SE, kt0);
#pragma unroll
    for (int d0 = NQR; d0 < DQ / 16; ++d0) *reinterpret_cast<bf16x8*>(Qs + (d0 - NQR) * 1024) = qpark[d0 - NQR];
    asm volatile("s_waitcnt vmcnt(0)" ::: "memory"); SWRITE(0, SE); __syncthreads();
    if (relA) { qkt<DQ, NQR>(pA0, pA1, K_lds, qr, Qs, r32, hi); MASK(pA0, pA1, 0); partialSM<DQ>(pA0, pA1, m_reg, mnA, alA); }
    SLOAD(SO, kt0 + KVBLK); if constexpr (SDEPTH == 2) { if (2 < NT) SLOAD(SE, kt0 + 2 * KVBLK); }
    SWAIT(); SWRITE(1, SO); __syncthreads();
    for (int j = 1; j + 1 < NT; j += 2) {
        relB = REL(j);
        SBAR(); if (relB) qkt<DQ, NQR>(pB0, pB1, K_lds + SHM_K, qr, Qs, r32, hi);
        SBAR(); SLOAD(SO, kt0 + (j + SDEPTH) * KVBLK); SBAR();
        if (relA) { bf16x8 pa0, pa1, pa2, pa3; finishSM(pA0, pA1, alA, l_reg, pa0, pa1, pa2, pa3); SBAR(); pv_d0(o, vb0, pa0, pa1, pa2, pa3); }
        alB = 1.f; if (relB) { MASK(pB0, pB1, j); partialSM<DQ>(pB0, pB1, m_reg, mnB, alB); }
        __syncthreads(); SWAIT(); SWRITE(0, SE);
        RESC(alB); __syncthreads();
        relA = REL(j + 1);
        SBAR(); if (relA) qkt<DQ, NQR>(pA0, pA1, K_lds, qr, Qs, r32, hi);
        SBAR(); if (SDEPTH == 1 || j + 3 < NT) SLOAD(SE, kt0 + (j + 1 + SDEPTH) * KVBLK); SBAR();
        if (relB) { bf16x8 pa0, pa1, pa2, pa3; finishSM(pB0, pB1, alB, l_reg, pa0, pa1, pa2, pa3); SBAR(); pv_d0(o, vb0 + SHM_V, pa0, pa1, pa2, pa3); }
        alA = 1.f; if (relA) { MASK(pA0, pA1, j + 1); partialSM<DQ>(pA0, pA1, m_reg, mnA, alA); }
        __syncthreads(); SWAIT(); SWRITE(1, SO);
        RESC(alA); __syncthreads();
    }
    relB = REL(NT - 1);
    SBAR(); if (relB) qkt<DQ, NQR>(pB0, pB1, K_lds + SHM_K, qr, Qs, r32, hi);
    if (relA) { bf16x8 pa0, pa1, pa2, pa3; finishSM(pA0, pA1, alA, l_reg, pa0, pa1, pa2, pa3); SBAR(); pv_d0(o, vb0, pa0, pa1, pa2, pa3); }
    alB = 1.f; if (relB) { MASK(pB0, pB1, NT - 1); partialSM<DQ>(pB0, pB1, m_reg, mnB, alB); }
    __syncthreads(); RESC(alB);
    if (relB) { bf16x8 pa0, pa1, pa2, pa3; finishSM(pB0, pB1, alB, l_reg, pa0, pa1, pa2, pa3); SBAR();
                pv_d0(o, vb0 + SHM_V, pa0, pa1, pa2, pa3); }
#undef REL
    if constexpr (MODE == 1) l_reg += __builtin_amdgcn_exp2f(sink * 1.4426950408889634f - m_reg * C);
    int q0e = q0; asm volatile("" : "+s"(q0e));
    if constexpr (MODE == 2) { if (hi == 0) lse_out[(long)(q0e + wid * 32 + r32) * ldl] = (m_reg * C + __builtin_amdgcn_logf(l_reg)) * 0.6931471805599453f; }
    if (hi == 0) li_l[r32] = l_reg; asm volatile("s_waitcnt lgkmcnt(0)" ::: "memory");
    float rli[16];
#pragma unroll
    for (int r = 0; r < 16; ++r) rli[r] = __builtin_amdgcn_rcpf(li_l[crow(r, hi)]);
    bf16_t* Ow = Ob + (long)(q0e + wid * 32) * ldo;
#pragma unroll
    for (int r = 0; r < 16; ++r) { const int orow = crow(r, hi);
#pragma unroll
        for (int d0 = 0; d0 < 4; ++d0) Ow[(long)orow * ldo + d0 * 32 + r32] = (bf16_t)(cvt_pk_bf16(o[d0][r] * rli[r], 0.f) & 0xffffu); }
    __syncthreads();
#undef CLAMPR
#undef SLOAD
#undef SWRITE
#undef SWAIT
#undef RESC
#undef MASK
}
}

__device__ __forceinline__ unsigned char* ws_fresh() {
    unsigned off = (unsigned)offsetof(Args, ws); asm volatile("" : "+s"(off));
    const __attribute__((address_space(4))) char* k = (const __attribute__((address_space(4))) char*)__builtin_amdgcn_kernarg_segment_ptr();
    return *(unsigned char* const __attribute__((address_space(4)))*)(k + off);
}
__device__ __forceinline__ void weight_tiles(const Args& a, LAS unsigned char* lds, int wv_, int t_first, int t_end, int stride, int j0) {
    int tid; { unsigned z_ = 0u; asm volatile("" : "+v"(z_)); tid = wv_ * 64 + (int)__builtin_amdgcn_mbcnt_hi(~0u, __builtin_amdgcn_mbcnt_lo(~0u, z_)); asm volatile("" : "+v"(tid)); }
    LAS unsigned* L = (LAS unsigned*)lds;
    const int c = tid & 15, nr = tid >> 4, n4 = (tid & 15) * 4, kp = tid >> 4;
    int j = j0;
    unsigned char* wsl = ws_fresh();
    for (int t0 = t_first; t0 < t_end; t0 += 2 * stride) {
        f32x4 r0[2][2], r1[2][2]; float g0[2][2], g1[2][2]; bf16_t* dst[2]; int Kc[2]; bool live[2];
#pragma unroll
        for (int u = 0; u < 2; ++u) {
            const int t = t0 + u * stride; live[u] = t < t_end; dst[u] = nullptr; Kc[u] = 0;
            if (live[u]) {
                while (t >= a.tile_start[j + 1]) ++j;
                const float* src = a.jobs[j].src; const float* gain = a.jobs[j].gain; const int K = a.jobs[j].K, N = a.jobs[j].N, Npad = a.jobs[j].Npad, blk = a.jobs[j].blk;
                const int lt = t - a.tile_start[j], ntn = Npad / 64, kt = lt / ntn, ntile = lt - kt * ntn, k0 = kt * 128, n0 = ntile * 64;
                const int drow0 = (n0 / blk) * a.jobs[j].blkstride + a.jobs[j].boff + (n0 % blk);
                dst[u] = (bf16_t*)(wsl + a.jobs[j].dst_off) + (size_t)drow0 * K + k0; Kc[u] = K;
#pragma unroll
                for (int i = 0; i < 2; ++i) { const int k = k0 + 2 * kp + 64 * i;
                    if (n0 < N) { r0[u][i] = *(const f32x4*)(src + (size_t)k * N + n0 + n4); r1[u][i] = *(const f32x4*)(src + (size_t)(k + 1) * N + n0 + n4); g0[u][i] = gain ? gain[k] : 1.f; g1[u][i] = gain ? gain[k + 1] : 1.f; }
                    else { r0[u][i] = (f32x4){0.f, 0.f, 0.f, 0.f}; r1[u][i] = r0[u][i]; g0[u][i] = 0.f; g1[u][i] = 0.f; } }
            }
        }
#pragma unroll
        for (int u = 0; u < 2; ++u) if (live[u]) {
#pragma unroll
            for (int i = 0; i < 2; ++i)
#pragma unroll
                for (int jj = 0; jj < 4; ++jj) L[u * 4160 + (n4 + jj) * 65 + kp + 32 * i] = cvt_pk_bf16(r0[u][i][jj] * g0[u][i], r1[u][i][jj] * g1[u][i]);
        }
        __syncthreads();
#pragma unroll
        for (int u = 0; u < 2; ++u) if (live[u]) {
#pragma unroll
            for (int i = 0; i < 2; ++i) { const int n = nr + 32 * i; const LAS unsigned* Lr = L + u * 4160 + n * 65 + 4 * c; u32x4 w; w.x = Lr[0]; w.y = Lr[1]; w.z = Lr[2]; w.w = Lr[3];
                *(u32x4*)(dst[u] + (size_t)n * Kc[u] + 8 * c) = w; }
        }
        __syncthreads();
    }
}
__device__ __forceinline__ void prep_phase(const Args& a, LAS unsigned char* lds, int wv_) {
    weight_tiles(a, lds, wv_, (int)blockIdx.x, a.tile_start[NJOBS_MAIN], (int)gridDim.x, 0);
    int tid; { unsigned z_ = 0u; asm volatile("" : "+v"(z_)); tid = wv_ * 64 + (int)__builtin_amdgcn_mbcnt_hi(~0u, __builtin_amdgcn_mbcnt_lo(~0u, z_)); asm volatile("" : "+v"(tid)); }
    const int G = gridDim.x, wid = tid >> 6, lane = tid & 63;
    unsigned char* wsl = ws_fresh();
    const float* x = a.in[0]; bf16_t* hb = (bf16_t*)(wsl + OFF_HB); float* ss = (float*)(wsl + OFF_SS);
    for (int row = blockIdx.x * 8 + wid; row < SEQ; row += G * 8) {
        float s = 0.f;
#pragma unroll
        for (int i = 0; i < 8; ++i) { const size_t o2 = (size_t)row * DM + (i * 64 + lane) * 4; const f32x4 v = *(const f32x4*)(x + o2);
            u32x2 w; w.x = cvt_pk_bf16(v[0], v[1]); w.y = cvt_pk_bf16(v[2], v[3]); *(u32x2*)(hb + o2) = w; s += (v[0] * v[0] + v[1] * v[1]) + (v[2] * v[2] + v[3] * v[3]); }
#pragma unroll
        for (int o = 32; o >= 1; o >>= 1) s += __shfl_xor(s, o);
        if (lane == 0) ss[row] = s;
    }
    for (int i = blockIdx.x * 512 + tid; i < 15 * SEQ; i += G * 512) ss[SEQ + i] = 0.f;
    { const float* p = a.in[1]; bf16_t* pb = (bf16_t*)(wsl + OFF_PBF);
      for (size_t i = (size_t)blockIdx.x * 512 + tid; i < (size_t)NLAYER * SEQ * PLE / 8; i += (size_t)G * 512) {
          const f32x4 v0 = *(const f32x4*)(p + i * 8), v1 = *(const f32x4*)(p + i * 8 + 4);
          u32x4 w; w.x = cvt_pk_bf16(v0[0], v0[1]); w.y = cvt_pk_bf16(v0[2], v0[3]); w.z = cvt_pk_bf16(v1[0], v1[1]); w.w = cvt_pk_bf16(v1[2], v1[3]); *(u32x4*)(pb + i * 8) = w; } }
    { const int* pos = (const int*)a.in[2]; f32x2* r32t = (f32x2*)(wsl + OFF_R32); f32x2* r64t = (f32x2*)(wsl + OFF_R64);
      for (int i = blockIdx.x * 512 + tid; i < SEQ * 48; i += G * 512) {
          const int tok = i / 48, f = i - tok * 48;
          const double inv = f < 16 ? a.inv32[f < 16 ? f : 0] : a.inv64[f < 16 ? 0 : f - 16];
          double tt = (double)pos[tok] * inv * 0.15915494309189533577; tt -= rint(tt);
          const float tf = (float)tt; f32x2 cs; cs.x = __builtin_amdgcn_cosf(tf); cs.y = __builtin_amdgcn_sinf(tf);
          if (f < 16) r32t[tok * 16 + f] = cs; else r64t[tok * 32 + (f - 16)] = cs; } }
}

__device__ __forceinline__ void post_hd128(bf16_t* buf, int ld, int nh, int nq, const float* gq, const float* gk, const f32x2* rope, int wv_) {
    int tid; { unsigned z_ = 0u; asm volatile("" : "+v"(z_)); tid = wv_ * 64 + (int)__builtin_amdgcn_mbcnt_hi(~0u, __builtin_amdgcn_mbcnt_lo(~0u, z_)); asm volatile("" : "+v"(tid)); }
    const int sub = tid & 15;
    const int npairs = SEQ * nh, step = (int)gridDim.x * 32;
    for (int p0 = (int)blockIdx.x * 32 + (tid >> 4); p0 < npairs; p0 += 4 * step) {
        u32x4 w[4]; bf16_t* ptr[4]; int tok[4], hd[4];
#pragma unroll
        for (int u = 0; u < 4; ++u) { const int p = p0 + u * step; const bool ok = p < npairs; const unsigned pp = (unsigned)(ok ? p : p0); tok[u] = (int)(pp / (unsigned)nh); hd[u] = (int)(pp - (unsigned)tok[u] * (unsigned)nh);
            ptr[u] = buf + (size_t)tok[u] * ld + hd[u] * 128 + sub * 8; w[u] = *(const u32x4*)ptr[u]; }
#pragma unroll
        for (int u = 0; u < 4; ++u) {
            float x[8]; unpack8(w[u], x);
            float s = 0.f;
#pragma unroll
            for (int j = 0; j < 8; ++j) s += x[j] * x[j];
            s += __shfl_xor(s, 1); s += __shfl_xor(s, 2); s += __shfl_xor(s, 4); s += __shfl_xor(s, 8);
            const float rstd = rsqrtf(s * (1.0f / 128.0f) + EPS);
            const float* g = (hd[u] < nq ? gq : gk) + sub * 8;
            float y[8], yp[8];
#pragma unroll
            for (int j = 0; j < 8; ++j) y[j] = x[j] * rstd * g[j];
#pragma unroll
            for (int j = 0; j < 8; ++j) yp[j] = __shfl_xor(y[j], 2);
            if (sub < 4) {
                const f32x2* cs = rope + (size_t)tok[u] * 16 + (sub & 1) * 8;
#pragma unroll
                for (int j = 0; j < 8; ++j) { const f32x2 c = cs[j]; y[j] = (sub < 2) ? (y[j] * c.x - yp[j] * c.y) : (y[j] * c.x + yp[j] * c.y); }
            }
            if (p0 + u * step < npairs) *(u32x4*)ptr[u] = pack8(y);
        }
    }
}
__device__ __forceinline__ void post_b(bf16_t* qraw, const bf16_t* kvraw, const bf16_t* krope, bf16_t* Kb, const float* gq, const float* gk, const f32x2* rope, int wv_) {
    int tid; { unsigned z_ = 0u; asm volatile("" : "+v"(z_)); tid = wv_ * 64 + (int)__builtin_amdgcn_mbcnt_hi(~0u, __builtin_amdgcn_mbcnt_lo(~0u, z_)); asm volatile("" : "+v"(tid)); }
    const int sub = tid & 31;
    const bool act = sub < 24, isrope = (sub >= 16) && act;
    const int npairs = SEQ * 16, step = (int)gridDim.x * 16;
    for (int p0 = (int)blockIdx.x * 16 + (tid >> 5); p0 < npairs; p0 += 2 * step) {
        u32x4 w[2][2]; int tok[2], hd[2];
#pragma unroll
        for (int u = 0; u < 2; ++u) { const int p = (p0 + u * step < npairs) ? p0 + u * step : p0; tok[u] = (p >> 4); hd[u] = (p & 15);
            w[u][0] = (u32x4){0u, 0u, 0u, 0u}; w[u][1] = (u32x4){0u, 0u, 0u, 0u};
            if (act) w[u][0] = *(const u32x4*)(qraw + (size_t)tok[u] * 3072 + hd[u] * 192 + sub * 8);
            if (sub < 16) w[u][1] = *(const u32x4*)(kvraw + (size_t)tok[u] * 4096 + hd[u] * 256 + sub * 8); else if (act) w[u][1] = *(const u32x4*)(krope + (size_t)tok[u] * 512 + (sub - 16) * 8); }
#pragma unroll
        for (int u = 0; u < 2; ++u) {
            const f32x2* cs = rope + (size_t)tok[u] * 32 + (sub & 3) * 8;
#pragma unroll
            for (int which = 0; which < 2; ++which) {
                float x[8]; unpack8(w[u][which], x);
                float s = 0.f;
#pragma unroll
                for (int j = 0; j < 8; ++j) s += x[j] * x[j];
                s += __shfl_xor(s, 1); s += __shfl_xor(s, 2); s += __shfl_xor(s, 4); s += __shfl_xor(s, 8); s += __shfl_xor(s, 16);
                const float rstd = rsqrtf(s * (1.0f / 192.0f) + EPS);
                const float* g = (which == 0 ? gq : gk) + (act ? sub * 8 : 0);
                float y[8], yp[8];
#pragma unroll
                for (int j = 0; j < 8; ++j) y[j] = x[j] * rstd * g[j];
#pragma unroll
                for (int j = 0; j < 8; ++j) yp[j] = __shfl_xor(y[j], 4);
                if (isrope) {
#pragma unroll
                    for (int j = 0; j < 8; ++j) { const f32x2 c = cs[j]; y[j] = (sub < 20) ? (y[j] * c.x - yp[j] * c.y) : (y[j] * c.x + yp[j] * c.y); }
                }
                if (act && (p0 + u * step < npairs)) { bf16_t* d = (which == 0 ? qraw : Kb) + (size_t)tok[u] * 3072 + hd[u] * 192 + sub * 8; *(u32x4*)d = pack8(y); }
            }
        }
    }
}
__device__ __forceinline__ void merge_c(const bf16_t* og, const float* lse, bf16_t* out, int wv_) {
    int tid; { unsigned z_ = 0u; asm volatile("" : "+v"(z_)); tid = wv_ * 64 + (int)__builtin_amdgcn_mbcnt_hi(~0u, __builtin_amdgcn_mbcnt_lo(~0u, z_)); asm volatile("" : "+v"(tid)); }
    const int sub = tid & 15;
    const int npairs = SEQ * 16, step = (int)gridDim.x * 32;
    for (int p0 = (int)blockIdx.x * 32 + (tid >> 4); p0 < npairs; p0 += 2 * step) {
        u32x4 wa[2], wb[2], wc[2]; float l0[2], l1[2], l2[2]; size_t off[2];
#pragma unroll
        for (int u = 0; u < 2; ++u) { const int p = (p0 + u * step < npairs) ? p0 + u * step : p0; off[u] = (size_t)p * 128 + sub * 8;
            l0[u] = lse[p]; l1[u] = lse[(size_t)SEQ * 16 + p]; l2[u] = lse[(size_t)2 * SEQ * 16 + p];
            wa[u] = *(const u32x4*)(og + off[u]); wb[u] = *(const u32x4*)(og + (size_t)SEQ * DM + off[u]); wc[u] = *(const u32x4*)(og + (size_t)2 * SEQ * DM + off[u]); }
#pragma unroll
        for (int u = 0; u < 2; ++u) {
            const float m = fmaxf(l0[u], fmaxf(l1[u], l2[u]));
            float e0 = __expf(l0[u] - m), e1 = __expf(l1[u] - m), e2 = __expf(l2[u] - m); const float inv = 1.0f / (e0 + e1 + e2); e0 *= inv; e1 *= inv; e2 *= inv;
            float a[8], b[8], c[8], y[8];
            unpack8(wa[u], a); unpack8(wb[u], b); unpack8(wc[u], c);
#pragma unroll
            for (int j = 0; j < 8; ++j) y[j] = e0 * a[j] + e1 * b[j] + e2 * c[j];
            if (p0 + u * step < npairs) *(u32x4*)(out + off[u]) = pack8(y);
        }
    }
}

constexpr int LDS_BYTES = pg8::STAGE_BYTES + 64 + 8192;
__device__ __forceinline__ unsigned char* ldr(unsigned char* p) { unsigned lo = (unsigned)(uintptr_t)p, hi = (unsigned)((uintptr_t)p >> 32); lo = __builtin_amdgcn_readfirstlane(lo); hi = __builtin_amdgcn_readfirstlane(hi); asm volatile("" : "+s"(lo), "+s"(hi)); return (unsigned char*)(((uintptr_t)hi << 32) | lo); }
__global__ void __launch_bounds__(512, 2) fwd_kernel(Args a) {
    extern __shared__ __attribute__((aligned(16))) unsigned char shm[];
    LAS unsigned char* lds = (LAS unsigned char*)shm;
    volatile LAS unsigned* misc = (volatile LAS unsigned*)(lds + pg8::STAGE_BYTES);
    const int wv_ = __builtin_amdgcn_readfirstlane((int)(threadIdx.x >> 6));
    if (threadIdx.x < 16) misc[threadIdx.x] = 0u;
    __syncthreads();
    (void)xcd_barrier_post((unsigned*)(ws_fresh() + OFF_BAR), misc);
    cg::grid_group grid = cg::this_grid();
#define GRID_BAR() do { XcdBarrier b_; b_.bar = (unsigned*)(ws_fresh() + OFF_BAR); b_.x = xb_xcc_id(); b_.st = (volatile LAS unsigned*)(lds + pg8::STAGE_BYTES); xcd_barrier(b_, wv_); } while (0)
#define WSP(T, off) ((T*)(ws + (off)))
#define SLACK_PREP(lo_, hi_) do { if (bid >= G / 2) { const int D0_ = a.tile_start[NJOBS_MAIN], DE_ = a.tile_start[NJOBS]; const int nr_ = G - G / 2; \
        int b_ = D0_ + (lo_) * nr_, e_ = (hi_) < 0 ? DE_ : D0_ + (hi_) * nr_; if (b_ > DE_) b_ = DE_; if (e_ > DE_) e_ = DE_; \
        weight_tiles(a, lds, wv_, b_ + (bid - G / 2), e_, nr_, NJOBS_MAIN); } } while (0)

    prep_phase(a, lds, wv_);
    grid.sync();

    for (int layer = 0; layer < NLAYER; ++layer) {
        const int kind = layer % 3, slot = layer / 3;
        int G = gridDim.x, bid = blockIdx.x; asm volatile("" : "+s"(G), "+s"(bid));
        if (kind == 0) {
            { unsigned char* ws = ws_fresh(); const unsigned char* WA = ws + OFF_A + (size_t)slot * (SZ_AIN + SZ_WO);
              pg8::EpiQKNorm E{WSP(bf16_t, OFF_R1), 3072, WSP(float, OFF_SS) + (size_t)(3 * layer) * SEQ, 8, 10, a.in[12] + slot * 128, a.in[13] + slot * 128, WSP(const f32x2, OFF_R32), (LAS float*)(lds + pg8::STAGE_BYTES + 64)}; run_gemm(lds, WSP(bf16_t, OFF_HB), (const bf16_t*)WA, 3072, DM, E, wv_); }
            if (layer == 0) SLACK_PREP(0, 17); else SLACK_PREP(50, -1);
            GRID_BAR();
            { unsigned char* ws = ws_fresh(); bf16_t* QKV = WSP(bf16_t, OFF_R1); bf16_t* ATT = WSP(bf16_t, OFF_ATT);
              for (int it = bid; it < 512; it += G) {
                const int hq = it & 15, qb = it >> 4, kvh = hq >> 2;
#ifndef NO_ATT_A
                att::attn_body<128, 1, 1>(QKV + hq * 128, 3072, QKV + 2048 + kvh * 128, 3072, QKV + 2560 + kvh * 128, 3072, ATT + hq * 128, DM, nullptr, 0,
                                          qb * 256, qb * 256 - 128, 8, SEQ, 128, a.in[14][slot * 16 + hq], (char*)shm, wv_);
#endif
              } }
            GRID_BAR();
        } else if (kind == 1) {
            { unsigned char* ws = ws_fresh(); float* SS = WSP(float, OFF_SS);
              pg8::EpiScaleBf16 E{WSP(bf16_t, OFF_R1 + R1_LAT), 512, 512, (size_t)SEQ * 512, SS + (size_t)(3 * layer) * SEQ, 1.0f / DM, SS + (size_t)13 * SEQ, SS + (size_t)14 * SEQ};
              run_gemm(lds, WSP(bf16_t, OFF_HB), WSP(const bf16_t, OFF_B), 1280, DM, E, wv_); }
            GRID_BAR();
            { unsigned char* ws = ws_fresh();
              pg8::EpiScaleBf16 E{WSP(bf16_t, OFF_R1 + R1_QRAW), 3072, 0, 0, WSP(float, OFF_SS) + (size_t)13 * SEQ, 1.0f / 512.0f, nullptr, nullptr};
              run_gemm(lds, WSP(bf16_t, OFF_R1 + R1_LAT), WSP(const bf16_t, OFF_B + SZ_BIN), 3072, 512, E, wv_); }
            { unsigned char* ws = ws_fresh();
              pg8::EpiScaleBf16 E{WSP(bf16_t, OFF_R1 + R1_KVRAW), 4096, 0, 0, WSP(float, OFF_SS) + (size_t)14 * SEQ, 1.0f / 512.0f, nullptr, nullptr};
              run_gemm(lds, WSP(bf16_t, OFF_R1 + R1_LAT) + (size_t)SEQ * 512, WSP(const bf16_t, OFF_B + SZ_BIN + SZ_BQ), 4096, 512, E, wv_); }
            GRID_BAR();
            { unsigned char* ws = ws_fresh();
              post_b(WSP(bf16_t, OFF_R1 + R1_QRAW), WSP(bf16_t, OFF_R1 + R1_KVRAW), WSP(bf16_t, OFF_R1 + R1_LAT) + (size_t)2 * SEQ * 512, WSP(bf16_t, OFF_R1 + R1_KB), a.in[21], a.in[22], WSP(const f32x2, OFF_R64), wv_); }
            GRID_BAR();
            { unsigned char* ws = ws_fresh(); bf16_t* QRAW = WSP(bf16_t, OFF_R1 + R1_QRAW); bf16_t* KVRAW = WSP(bf16_t, OFF_R1 + R1_KVRAW); bf16_t* KB = WSP(bf16_t, OFF_R1 + R1_KB); bf16_t* ATT = WSP(bf16_t, OFF_ATT);
              for (int it = bid; it < 512; it += G) {
                const int hq = (it & 7) + 8 * (it >> 8), qb = (it >> 3) & 31;
#ifndef NO_ATT_B
                att::attn_body<192, 0, 1>(QRAW + hq * 192, 3072, KB + hq * 192, 3072, KVRAW + hq * 256 + 128, 4096, ATT + hq * 128, DM, nullptr, 0,
                                          qb * 256, 0, 128, SEQ, 0, 0.f, (char*)shm, wv_);
#endif
              } }
            GRID_BAR();
        } else {
            { unsigned char* ws = ws_fresh();
              pg8::EpiQKNorm E{WSP(bf16_t, OFF_R1), 10240, WSP(float, OFF_SS) + (size_t)(3 * layer) * SEQ, 24, 32, a.in[25], a.in[26], WSP(const f32x2, OFF_R32), (LAS float*)(lds + pg8::STAGE_BYTES + 64)}; run_gemm(lds, WSP(bf16_t, OFF_HB), WSP(const bf16_t, OFF_C), 10240, DM, E, wv_); }
            GRID_BAR();
            { unsigned char* ws = ws_fresh(); bf16_t* QKV = WSP(bf16_t, OFF_R1); bf16_t* OG = WSP(bf16_t, OFF_OG); float* LSE = WSP(float, OFF_LSE);
              for (int it = bid; it < 1536; it += G) {
                const int g = it >> 9, r = it & 511, hq = r & 15, rest = r >> 4;
                const int dl = g == 0 ? 0 : (g == 1 ? 2 : 4), dil = 1 << dl, Lc = SEQ >> dl, nqb = Lc >> 8;
                const int ch = rest / nqb, qb = rest - ch * nqb;
#ifndef NO_ATT_C
                att::attn_body<128, 2, 1>(QKV + (size_t)ch * 10240 + (g * 16 + hq) * 128, (long)dil * 10240, QKV + (size_t)ch * 10240 + 6144 + hq * 128, (long)dil * 10240,
                                          QKV + (size_t)ch * 10240 + 8192 + hq * 128, (long)dil * 10240, OG + (size_t)g * SEQ * DM + (size_t)ch * DM + hq * 128, (long)dil * DM,
                                          LSE + (size_t)g * SEQ * 16 + ch * 16 + hq, (long)dil * 16, qb * 256, qb * 256 - 64, 6, Lc, 64, 0.f, (char*)shm, wv_);
#endif
              } }
            GRID_BAR();
            { unsigned char* ws = ws_fresh(); merge_c(WSP(bf16_t, OFF_OG), WSP(float, OFF_LSE), WSP(bf16_t, OFF_ATT), wv_); }
            GRID_BAR();
        }
        { unsigned char* ws = ws_fresh();
          const size_t wo = kind == 0 ? OFF_A + (size_t)slot * (SZ_AIN + SZ_WO) + SZ_AIN : (kind == 1 ? OFF_B + SZ_BIN + SZ_BQ + SZ_BKV : OFF_C + SZ_CIN);
          pg8::EpiResid E{layer == 0 ? a.in[0] : a.out, a.out, WSP(bf16_t, OFF_HB), nullptr, nullptr, WSP(float, OFF_SS) + (size_t)(3 * layer + 1) * SEQ}; run_gemm(lds, WSP(bf16_t, OFF_ATT), (const bf16_t*)(ws + wo), DM, DM, E, wv_); }
        GRID_BAR();
        { unsigned char* ws = ws_fresh();
          pg8::EpiSwiglu E{WSP(bf16_t, OFF_R1), WSP(float, OFF_SS) + (size_t)(3 * layer + 1) * SEQ}; run_gemm(lds, WSP(bf16_t, OFF_HB), (const bf16_t*)(ws + OFF_WL + (size_t)layer * SZ_LAYER), 11264, DM, E, wv_); }
        if ((int)blockIdx.x >= G / 2) {
          unsigned char* ws = ws_fresh();
          pg8::EpiScaleBf16 E{WSP(bf16_t, OFF_PP), DM, 0, 0, nullptr, 0.f, nullptr, nullptr};
          pg8::Gemm g{WSP(bf16_t, OFF_PBF) + (size_t)layer * SEQ * PLE, (const bf16_t*)(ws + OFF_WL + (size_t)layer * SZ_LAYER + SZ_WGU + SZ_WD + SZ_WPG), SEQ, DM, PLE};
          pg8::StaticOrder S; S.init(SEQ, DM, G - G / 2, (int)blockIdx.x - G / 2);
          pg8::gemm_phase<pg8::EpiScaleBf16, pg8::StaticOrder>(lds, g, S, E, wv_); }
        if (layer < 3) { const int lo_s = layer == 0 ? 17 : (layer == 1 ? 28 : 39), hi_s = layer == 0 ? 28 : (layer == 1 ? 39 : 50); SLACK_PREP(lo_s, hi_s); }
        GRID_BAR();
        { unsigned char* ws = ws_fresh();
          pg8::EpiResid E{a.out, a.out, WSP(bf16_t, OFF_HB), nullptr, nullptr, WSP(float, OFF_SS) + (size_t)(3 * layer + 2) * SEQ}; run_gemm(lds, WSP(bf16_t, OFF_R1), (const bf16_t*)(ws + OFF_WL + (size_t)layer * SZ_LAYER + SZ_WGU), DM, FF, E, wv_); }
        GRID_BAR();
        { unsigned char* ws = ws_fresh();
          pg8::EpiPle E{a.out, a.out, WSP(bf16_t, OFF_HB), WSP(bf16_t, OFF_PP), WSP(float, OFF_SS) + (size_t)(3 * layer + 2) * SEQ, WSP(float, OFF_SS) + (size_t)(3 * layer + 3) * SEQ};
          run_gemm(lds, WSP(bf16_t, OFF_HB), (const bf16_t*)(ws + OFF_WL + (size_t)layer * SZ_LAYER + SZ_WGU + SZ_WD), DM, DM, E, wv_); }
        if (layer + 1 < NLAYER) GRID_BAR();
    }
}

extern "C" void kernel_launch(void* const* d_in, const int* in_sizes, int n_in, void* d_out, int out_size, void* d_ws, size_t ws_size, hipStream_t stream) {
    static int grid = 0;
    if (grid == 0) {
        if (n_in != 28 || out_size != SEQ * DM || ws_size < WS_END) { fprintf(stderr, "kernel_launch: unexpected shapes: n_in %d out %d ws %zu (need %zu)\n", n_in, out_size, ws_size, (size_t)WS_END); grid = -1; return; }
        int dev = 0, cus = 0, per_cu = 0;
        if (hipGetDevice(&dev) != hipSuccess || hipDeviceGetAttribute(&cus, hipDeviceAttributeMultiprocessorCount, dev) != hipSuccess) { grid = -1; return; }
        if (hipFuncSetAttribute((const void*)fwd_kernel, hipFuncAttributeMaxDynamicSharedMemorySize, LDS_BYTES) != hipSuccess) { fprintf(stderr, "kernel_launch: hipFuncSetAttribute failed\n"); grid = -1; return; }
        if (hipOccupancyMaxActiveBlocksPerMultiprocessor(&per_cu, (const void*)fwd_kernel, 512, LDS_BYTES) != hipSuccess || per_cu < 1) { fprintf(stderr, "kernel_launch: occupancy query says %d\n", per_cu); (void)hipGetLastError(); per_cu = 1; }
        grid = cus * 1;
    }
    if (grid < 0) return;
    (void)hipMemsetAsync((char*)d_ws + OFF_BAR, 0, 16384, stream);
    Args a{};
    for (int i = 0; i < 28; ++i) a.in[i] = (const float*)d_in[i];
    a.out = (float*)d_out; a.ws = (unsigned char*)d_ws;
    for (int i = 0; i < 16; ++i) a.inv32[i] = std::pow(500000.0, -(double)i * 2.0 / 32.0);
    for (int i = 0; i < 32; ++i) a.inv64[i] = std::pow(500000.0, -(double)i * 2.0 / 64.0);
    int nj = 0;
    auto add = [&](const float* src, const float* gain, size_t dst, int K, int N, int Npad, int blk, int blkstride, int boff) {
        WJob& J = a.jobs[nj++]; J.src = src; J.gain = gain; J.dst_off = dst; J.K = K; J.N = N; J.Npad = Npad; J.blk = blk; J.blkstride = blkstride; J.boff = boff; };
    const float* const* in = (const float* const*)d_in;
    auto add_layer = [&](int i) {
        const size_t wl = OFF_WL + (size_t)i * SZ_LAYER;
        add(in[8] + (size_t)i * DM * FF, in[4] + i * DM, wl, DM, FF, FF, 128, 256, 0);
        add(in[9] + (size_t)i * DM * FF, in[4] + i * DM, wl, DM, FF, FF, 128, 256, 128);
        add(in[10] + (size_t)i * FF * DM, nullptr, wl + SZ_WGU, FF, DM, DM, DM, 0, 0);
        add(in[6] + (size_t)i * DM * DM, in[5] + i * DM, wl + SZ_WGU + SZ_WD, DM, DM, DM, DM, 0, 0);
        add(in[7] + (size_t)i * PLE * DM, nullptr, wl + SZ_WGU + SZ_WD + SZ_WPG, PLE, DM, DM, DM, 0, 0);
    };
    auto add_a = [&](int sl) {
        const size_t wa = OFF_A + (size_t)sl * (SZ_AIN + SZ_WO);
        add(in[11] + (size_t)sl * DM * 3072, in[3] + (3 * sl) * DM, wa, DM, 3072, 3072, 3072, 0, 0);
        add(in[15] + (size_t)sl * DM * DM, nullptr, wa + SZ_AIN, DM, DM, DM, DM, 0, 0);
    };
    add_layer(0); add_layer(1); add_a(0);
    add(in[16], in[3] + 1 * DM, OFF_B, DM, 1088, 1280, 1280, 0, 0);
    add(in[19], in[17], OFF_B + SZ_BIN, 512, 3072, 3072, 3072, 0, 0);
    add(in[20], in[18], OFF_B + SZ_BIN + SZ_BQ, 512, 4096, 4096, 4096, 0, 0);
    add(in[23], nullptr, OFF_B + SZ_BIN + SZ_BQ + SZ_BKV, DM, DM, DM, DM, 0, 0);
    add(in[24], in[3] + 2 * DM, OFF_C, DM, 10240, 10240, 10240, 0, 0);
    add(in[27], nullptr, OFF_C + SZ_CIN, DM, DM, DM, DM, 0, 0);
    { const int i = 2; const size_t wl = OFF_WL + (size_t)i * SZ_LAYER;
      add(in[10] + (size_t)i * FF * DM, nullptr, wl + SZ_WGU, FF, DM, DM, DM, 0, 0);
      add(in[6] + (size_t)i * DM * DM, in[5] + i * DM, wl + SZ_WGU + SZ_WD, DM, DM, DM, DM, 0, 0);
      add(in[7] + (size_t)i * PLE * DM, nullptr, wl + SZ_WGU + SZ_WD + SZ_WPG, PLE, DM, DM, DM, 0, 0);
      add(in[8] + (size_t)i * DM * FF, in[4] + i * DM, wl, DM, FF, FF, 128, 256, 0);
      add(in[9] + (size_t)i * DM * FF, in[4] + i * DM, wl, DM, FF, FF, 128, 256, 128); }
    add_a(1); add_layer(3);
    a.tile_start[0] = 0;
    for (int j = 0; j < NJOBS; ++j) a.tile_start[j + 1] = a.tile_start[j] + (a.jobs[j].K / 128) * (a.jobs[j].Npad / 64);
    a.tile_start[NJOBS + 1] = 0x7fffffff;
    void* args[] = {&a};
    hipError_t e = hipLaunchCooperativeKernel((const void*)fwd_kernel, dim3(grid), dim3(512), args, LDS_BYTES, stream);
    if (e != hipSuccess) fprintf(stderr, "kernel_launch: cooperative launch failed: %s (grid %d)\n", hipGetErrorString(e), grid);
}
```

```cpp
#include <hip/hip_runtime.h>
#include <hip/hip_cooperative_groups.h>
#include <cstdio>
#include <cmath>
#include <cstdint>
namespace cg = cooperative_groups;

#define LAS __attribute__((address_space(3)))
typedef unsigned short bf16_t;
typedef short bf16x8 __attribute__((ext_vector_type(8)));
typedef short s16x4 __attribute__((ext_vector_type(4)));
typedef float f32x4 __attribute__((ext_vector_type(4)));
typedef float f32x2 __attribute__((ext_vector_type(2)));
typedef float f32x16 __attribute__((ext_vector_type(16)));
typedef unsigned u32x4 __attribute__((ext_vector_type(4)));
typedef unsigned u32x2 __attribute__((ext_vector_type(2)));

constexpr int SEQ = 8192, DM = 2048, FF = 5632, PLE = 256, NLAYER = 4;
constexpr float EPS = 1e-6f;
constexpr int NJOBS = 30, NJOBS_MAIN = 21;

constexpr size_t SZ_WGU = 11264ull * 2048 * 2, SZ_WD = 2048ull * 5632 * 2, SZ_WPG = 2048ull * 2048 * 2, SZ_WPP = 2048ull * 256 * 2;
constexpr size_t SZ_LAYER = SZ_WGU + SZ_WD + SZ_WPG + SZ_WPP;
constexpr size_t SZ_WO = 2048ull * 2048 * 2, SZ_AIN = 3072ull * 2048 * 2, SZ_BIN = 1280ull * 2048 * 2, SZ_BQ = 3072ull * 512 * 2, SZ_BKV = 4096ull * 512 * 2, SZ_CIN = 10240ull * 2048 * 2;
constexpr size_t OFF_WL = 0;
constexpr size_t OFF_A = OFF_WL + 4 * SZ_LAYER;
constexpr size_t OFF_B = OFF_A + 2 * (SZ_AIN + SZ_WO);
constexpr size_t OFF_C = OFF_B + SZ_BIN + SZ_BQ + SZ_BKV + SZ_WO;
constexpr size_t OFF_WEND = OFF_C + SZ_CIN + SZ_WO;
constexpr size_t OFF_HB = OFF_WEND;
constexpr size_t OFF_PBF = OFF_HB + 8192ull * 2048 * 2;
constexpr size_t OFF_PP = OFF_PBF + 4ull * 8192 * 256 * 2;
constexpr size_t OFF_ATT = OFF_PP + 8192ull * 2048 * 2;
constexpr size_t OFF_OG = OFF_ATT + 8192ull * 2048 * 2;
constexpr size_t OFF_LSE = OFF_OG + 3ull * 8192 * 2048 * 2;
constexpr size_t OFF_SS = OFF_LSE + 3ull * 8192 * 16 * 4;
constexpr size_t OFF_R32 = OFF_SS + 16ull * 8192 * 4;
constexpr size_t OFF_R64 = OFF_R32 + 8192ull * 16 * 8;
constexpr size_t OFF_BAR = OFF_R64 + 8192ull * 32 * 8;
constexpr size_t OFF_R1 = OFF_BAR + 16384;
constexpr size_t R1_LAT = 0, R1_QRAW = 3ull * 8192 * 512 * 2, R1_KVRAW = R1_QRAW + 8192ull * 3072 * 2, R1_KB = R1_KVRAW + 8192ull * 4096 * 2, R1_END = R1_KB + 8192ull * 3072 * 2;
constexpr size_t WS_END = OFF_R1 + R1_END;
static_assert(8192ull * 10240 * 2 <= R1_END && 8192ull * 5632 * 2 <= R1_END, "R1 too small");

struct WJob { const float* src; const float* gain; unsigned long long dst_off; int K, N, Npad, blk, blkstride, boff; };
struct Args {
    const float* in[28]; float* out; unsigned char* ws;
    double inv32[16]; double inv64[32];
    WJob jobs[NJOBS]; int tile_start[NJOBS + 2];
};

__device__ __forceinline__ unsigned cvt_pk_bf16(float lo, float hi) { unsigned r; asm volatile("v_cvt_pk_bf16_f32 %0, %1, %2" : "=v"(r) : "v"(lo), "v"(hi)); return r; }
__device__ __forceinline__ float bf_lo(unsigned w) { return __uint_as_float(w << 16); }
__device__ __forceinline__ float bf_hi(unsigned w) { return __uint_as_float(w & 0xffff0000u); }
__device__ __forceinline__ void unpack8(const u32x4 w, float (&x)[8]) { x[0] = bf_lo(w.x); x[1] = bf_hi(w.x); x[2] = bf_lo(w.y); x[3] = bf_hi(w.y); x[4] = bf_lo(w.z); x[5] = bf_hi(w.z); x[6] = bf_lo(w.w); x[7] = bf_hi(w.w); }
__device__ __forceinline__ u32x4 pack8(const float (&x)[8]) { u32x4 w; w.x = cvt_pk_bf16(x[0], x[1]); w.y = cvt_pk_bf16(x[2], x[3]); w.z = cvt_pk_bf16(x[4], x[5]); w.w = cvt_pk_bf16(x[6], x[7]); return w; }

__device__ __forceinline__ float xor32(float x, bool lower_half) { auto rr = __builtin_amdgcn_permlane32_swap(__float_as_uint(x), __float_as_uint(x), false, false); return __uint_as_float(lower_half ? rr[1] : rr[0]); }
#define XB_TMO      128
#define XB_XCNT(j)  (256  + 64 * (j))
#define XB_XSUB(j)  (1280 + 64 * (j))
#define XB_XGEN(j)  (2304 + 64 * (j))
#define XB_TOP      3328
#define XB_TOPGEN   3392
#define XCD_BAR_WORDS 3456
#define XB_SPIN_CAP (1u << 24)
__device__ __forceinline__ unsigned xb_ld(unsigned* p)              { return __hip_atomic_load(p, __ATOMIC_RELAXED, __HIP_MEMORY_SCOPE_AGENT); }
__device__ __forceinline__ unsigned xb_add(unsigned* p, unsigned v) { return __hip_atomic_fetch_add(p, v, __ATOMIC_RELAXED, __HIP_MEMORY_SCOPE_AGENT); }
__device__ __forceinline__ unsigned xb_xcc_id() { return (unsigned)__builtin_amdgcn_s_getreg((3 << 11) | 20) & 0xFu; }
#define XB_SPIN(cond, bar) do { unsigned _sp = 0; while (cond) { __builtin_amdgcn_s_sleep(1); \
    if ((++_sp & 255u) == 0u) { if (xb_ld(&(bar)[XB_TMO])) break; if (_sp > XB_SPIN_CAP) { atomicAdd(&(bar)[XB_TMO], 1u); break; } } } } while (0)
struct XcdBarrier { unsigned* bar; unsigned x; volatile LAS unsigned* st; };
__device__ __forceinline__ XcdBarrier xcd_barrier_post(unsigned* bar, volatile LAS unsigned* st) {
    XcdBarrier b; b.bar = bar; b.x = xb_xcc_id(); b.st = st;
    if (threadIdx.x == 0) (void)xb_add(&bar[XB_XCNT(b.x)], 1u);
    return b;
}
__device__ __forceinline__ void xcd_barrier_complete(unsigned* bar, unsigned x, unsigned& nloc, unsigned& nx) {
    const unsigned G = gridDim.x * gridDim.y * gridDim.z;
    unsigned sum, cnt, mine, sp = 0u;
    for (;;) {
        sum = 0u; cnt = 0u; mine = 0u;
#pragma unroll
        for (unsigned j = 0; j < 16; ++j) { const unsigned c = xb_ld(&bar[XB_XCNT(j)]); sum += c; cnt += (c > 0u) ? 1u : 0u; mine = (j == x) ? c : mine; }
        if (sum == G) break;
        __builtin_amdgcn_s_sleep(1);
        if ((++sp & 255u) == 0u) { if (xb_ld(&bar[XB_TMO])) break; if (sp > XB_SPIN_CAP) { atomicAdd(&bar[XB_TMO], 1u); break; } }
    }
    nloc = mine > 0u ? mine : 1u; nx = cnt > 0u ? cnt : 1u;
}
__device__ __forceinline__ void xcd_barrier(const XcdBarrier& b, int wv_) {
    asm volatile("s_waitcnt vmcnt(0)" ::: "memory");
    __syncthreads();
    if (wv_ == 0 && __builtin_amdgcn_mbcnt_hi(~0u, __builtin_amdgcn_mbcnt_lo(~0u, 0u)) == 0u) {
        unsigned* bar = b.bar;
        __builtin_amdgcn_s_waitcnt(0);
        unsigned nloc = b.st[0], nx = b.st[1];
        if (nloc == 0u) { xcd_barrier_complete(bar, b.x, nloc, nx); b.st[0] = nloc; b.st[1] = nx; }
        const unsigned old = xb_add(&bar[XB_XSUB(b.x)], 1u);
        const unsigned gen = old / nloc;
        if (old + 1u == (gen + 1u) * nloc) {
            __builtin_amdgcn_fence(__ATOMIC_RELEASE, "agent");
            asm volatile("s_waitcnt vmcnt(0)" ::: "memory");
            const unsigned og = xb_add(&bar[XB_TOP], 1u);
            const unsigned tg = og / nx;
            if (og + 1u == (tg + 1u) * nx) xb_add(&bar[XB_TOPGEN], 1u);
            else XB_SPIN(xb_ld(&bar[XB_TOPGEN]) == tg, bar);
            __builtin_amdgcn_fence(__ATOMIC_ACQUIRE, "agent");
            xb_add(&bar[XB_XGEN(b.x)], 1u);
            asm volatile("s_waitcnt vmcnt(0)" ::: "memory");
        } else {
            XB_SPIN(xb_ld(&bar[XB_XGEN(b.x)]) == gen, bar);
            __builtin_amdgcn_fence(__ATOMIC_ACQUIRE, "agent");
            asm volatile("s_waitcnt vmcnt(0)" ::: "memory");
        }
    }
    __syncthreads();
}

namespace pg8 {
constexpr int BM = 256, BK = 64, HALF = 128, HTB = HALF * BK * 2, STAGE_BYTES = 8 * HTB, NXCD = 8, WGM = 8;
__device__ __forceinline__ int lds_byte(int r, int c) { const int st = (r >> 4) * 2 + (c >> 5), rr = r & 15, cc = c & 31, ob = rr * 64 + cc * 2; return st * 1024 + (ob ^ (((ob >> 9) & 1) << 5)); }
__device__ __forceinline__ void stage_rc(int b, int& R, int& C) { const int st = b / 1024, sb = b % 1024, swz = sb ^ (((sb >> 9) & 1) << 5); R = (st >> 1) * 16 + swz / 64; C = (st & 1) * 32 + (swz % 64) / 2; }
__device__ __forceinline__ int perm32(int rho) { const int n = rho >> 4, i = rho & 15; return 8 * (i >> 2) + 4 * n + (i & 3); }
struct Unit { int pm, pn; };
struct Gemm { const bf16_t* A; const bf16_t* Bt; int M, N, K; };
struct StaticOrder {
    int nM, nN, nwg, G, c;
    __device__ void init(int M, int N, int G_, int c_) { nM = M / BM; nN = N / BM; nwg = nM * nN; G = G_; c = c_; }
    __device__ bool next(int i, Unit& u) const {
        const long L = (long)i * G + c; if (L >= nwg) return false;
        int wgid = (int)L; { const int q = nwg / NXCD, r = nwg % NXCD, xcd = wgid % NXCD, off = wgid / NXCD; wgid = (xcd < r ? xcd * (q + 1) : r * (q + 1) + (xcd - r) * q) + off; }
        const int nig = WGM * nN, gid = wgid / nig, fm = gid * WGM, gsz = (nM - fm) < WGM ? (nM - fm) : WGM;
        u.pm = fm + ((wgid % nig) % gsz); u.pn = (wgid % nig) / gsz; return true;
    }
    __device__ __forceinline__ void a_ready(const Unit&) const {}
    __device__ __forceinline__ void done(const Unit&) const {}
};

struct EpiScaleBf16 {
    static constexpr bool PERM = true;
    bf16_t* O; int ldc; int split_cols; size_t split_stride; const float* ss; float inv_dim; float* sso0; float* sso1;
    __device__ __forceinline__ void operator()(const f32x4 (&acc)[2][2][4][2], const Unit& u, int wr, int wc, int fr, int fq) const {
        const int row0 = u.pm * BM + wr * 64 + fr; int colt = u.pn * BM; bf16_t* base = O;
        if (split_cols) { const int t = colt / split_cols; base += (size_t)t * split_stride; colt -= t * split_cols; }
        const int col0 = colt + wc * 32 + 8 * fq;
        float* sso = sso0 ? (u.pn < 2 ? sso0 : (u.pn < 4 ? sso1 : nullptr)) : nullptr;
        float rsv[2][4];
#pragma unroll
        for (int ai = 0; ai < 2; ++ai)
#pragma unroll
            for (int m = 0; m < 4; ++m) rsv[ai][m] = ss ? ss[row0 + ai * HALF + m * 16] : 0.f;
#pragma unroll
        for (int ai = 0; ai < 2; ++ai)
#pragma unroll
            for (int m = 0; m < 4; ++m) {
                const int row = row0 + ai * HALF + m * 16;
                const float rs = ss ? rsqrtf(rsv[ai][m] * inv_dim + EPS) : 1.0f;
                float part = 0.f;
                bf16_t* rowp = base + (size_t)row * ldc + col0;
#pragma unroll
                for (int bj = 0; bj < 2; ++bj) {
                    const f32x4 v0 = acc[ai][bj][m][0] * rs, v1 = acc[ai][bj][m][1] * rs;
                    part += (v0[0] * v0[0] + v0[1] * v0[1]) + (v0[2] * v0[2] + v0[3] * v0[3]) + (v1[0] * v1[0] + v1[1] * v1[1]) + (v1[2] * v1[2] + v1[3] * v1[3]);
                    u32x4 w; w.x = cvt_pk_bf16(v0[0], v0[1]); w.y = cvt_pk_bf16(v0[2], v0[3]); w.z = cvt_pk_bf16(v1[0], v1[1]); w.w = cvt_pk_bf16(v1[2], v1[3]);
                    *(u32x4*)(rowp + bj * HALF) = w;
                }
                if (sso) { part += __shfl_xor(part, 16); part += __shfl_xor(part, 32); if (fq == 0) unsafeAtomicAdd(sso + row, part); }
            }
    }
};
struct EpiQKNorm {
    static constexpr bool PERM = true, TWICE = false;
    bf16_t* O; int ldc; const float* ss; int nq_tiles, nqk_tiles; const float* gq; const float* gk; const f32x2* rope; LAS float* xch;
    __device__ __forceinline__ void operator()(const f32x4 (&acc)[2][2][4][2], const Unit& u, int wr, int wc, int fr, int fq) const {
        const int row0 = u.pm * BM + wr * 64 + fr, col0 = u.pn * BM + wc * 32 + 8 * fq;
        float rsv[2][4];
#pragma unroll
        for (int ai = 0; ai < 2; ++ai)
#pragma unroll
            for (int m = 0; m < 4; ++m) rsv[ai][m] = rsqrtf(ss[row0 + ai * HALF + m * 16] * (1.0f / DM) + EPS);
        if (u.pn >= nqk_tiles) {
#pragma unroll
            for (int ai = 0; ai < 2; ++ai)
#pragma unroll
                for (int m = 0; m < 4; ++m) {
                    const float rs = rsv[ai][m]; bf16_t* rowp = O + (size_t)(row0 + ai * HALF + m * 16) * ldc + col0;
#pragma unroll
                    for (int bj = 0; bj < 2; ++bj) {
                        const f32x4 v0 = acc[ai][bj][m][0] * rs, v1 = acc[ai][bj][m][1] * rs;
                        u32x4 w; w.x = cvt_pk_bf16(v0[0], v0[1]); w.y = cvt_pk_bf16(v0[2], v0[3]); w.z = cvt_pk_bf16(v1[0], v1[1]); w.w = cvt_pk_bf16(v1[2], v1[3]);
                        *(u32x4*)(rowp + bj * HALF) = w;
                    }
                }
            return;
        }
        const float* g = (u.pn < nq_tiles ? gq : gk) + wc * 32 + 8 * fq;
        float gv[8];
#pragma unroll
        for (int j = 0; j < 8; ++j) gv[j] = g[j];
#pragma unroll
        for (int ai = 0; ai < 2; ++ai)
#pragma unroll
            for (int m = 0; m < 4; ++m) {
                const float rs = rsv[ai][m];
#pragma unroll
                for (int bj = 0; bj < 2; ++bj) {
                    const f32x4 v0 = acc[ai][bj][m][0] * rs, v1 = acc[ai][bj][m][1] * rs;
                    float part = (v0[0] * v0[0] + v0[1] * v0[1]) + (v0[2] * v0[2] + v0[3] * v0[3]) + (v1[0] * v1[0] + v1[1] * v1[1]) + (v1[2] * v1[2] + v1[3] * v1[3]);
                    part += __shfl_xor(part, 16); part += xor32(part, fq < 2);
                    if (fq == 0) xch[((ai * HALF + wr * 64 + m * 16 + fr) * 2 + bj) * 4 + wc] = part;
                }
            }
        asm volatile("s_waitcnt lgkmcnt(0)" ::: "memory"); __builtin_amdgcn_s_barrier(); asm volatile("" ::: "memory");
        f32x2 csb[2][8];
#define QKN_LOADCS(g_, slot_) do { if (wc == 0) { const size_t rr_ = (size_t)(u.pm * BM + ((g_) >> 2) * HALF + wr * 64 + ((g_) & 3) * 16 + fr) * 16 + (fq & 1) * 8; \
        _Pragma("unroll") for (int j_ = 0; j_ < 8; ++j_) csb[slot_][j_] = rope[rr_ + j_]; } } while (0)
        QKN_LOADCS(0, 0);
#pragma unroll
        for (int g = 0; g < 8; ++g) {
            {
                const int ai = g >> 2, m = g & 3;
                if (g + 1 < 8) { if ((g & 1) == 0) QKN_LOADCS(g + 1, 1); else QKN_LOADCS(g + 1, 0); }
                asm volatile("" ::: "memory");
                const f32x2 (&cs)[8] = csb[g & 1];
                const int rl = ai * HALF + wr * 64 + m * 16 + fr, row = u.pm * BM + rl; const float rs = rsv[ai][m];
#pragma unroll
                for (int bj = 0; bj < 2; ++bj) {
                    const f32x4 t4 = *(const LAS f32x4*)(xch + (rl * 2 + bj) * 4);
                    const float sc = rs * rsqrtf(((t4[0] + t4[1]) + (t4[2] + t4[3])) * (1.0f / 128.0f) + EPS);
                    float y[8];
#pragma unroll
                    for (int j = 0; j < 4; ++j) { y[j] = acc[ai][bj][m][0][j] * sc * gv[j]; y[4 + j] = acc[ai][bj][m][1][j] * sc * gv[4 + j]; }
                    if (wc == 0) {
#pragma unroll
                        for (int j = 0; j < 8; ++j) { const float yp = xor32(y[j], fq < 2); y[j] = (fq < 2) ? (y[j] * cs[j].x - yp * cs[j].y) : (y[j] * cs[j].x + yp * cs[j].y); }
                    }
                    *(u32x4*)(O + (size_t)row * ldc + col0 + bj * HALF) = pack8(y);
                }
                asm volatile("" ::: "memory");
            }
        }
#undef QKN_LOADCS
    }
};
struct EpiSwiglu {
    static constexpr bool PERM = true;
    bf16_t* O; const float* ss;
    __device__ __forceinline__ void operator()(const f32x4 (&acc)[2][2][4][2], const Unit& u, int wr, int wc, int fr, int fq) const {
        const int row0 = u.pm * BM + wr * 64 + fr, col0 = u.pn * HALF + wc * 32 + 8 * fq;
        float rsv[2][4];
#pragma unroll
        for (int ai = 0; ai < 2; ++ai)
#pragma unroll
            for (int m = 0; m < 4; ++m) rsv[ai][m] = ss[row0 + ai * HALF + m * 16];
#pragma unroll
        for (int ai = 0; ai < 2; ++ai)
#pragma unroll
            for (int m = 0; m < 4; ++m) {
                const int row = row0 + ai * HALF + m * 16;
                const float rs = rsqrtf(rsv[ai][m] * (1.0f / DM) + EPS);
                float o[8];
#pragma unroll
                for (int n = 0; n < 2; ++n)
#pragma unroll
                    for (int j = 0; j < 4; ++j) {
                        const float g = acc[ai][0][m][n][j] * rs, uu = acc[ai][1][m][n][j] * rs;
                        o[n * 4 + j] = g * __builtin_amdgcn_rcpf(1.0f + __expf(-g)) * uu;
                    }
                *(u32x4*)(O + (size_t)row * FF + col0) = pack8(o);
            }
    }
};
template <bool PLE_> struct EpiResT {
    static constexpr bool PERM = false;
    const float* Hin; float* H; bf16_t* HB; const bf16_t* PP; const float* ss; float* sso;
    __device__ __forceinline__ void operator()(const f32x4 (&acc)[2][2][4][2], const Unit& u, int wr, int wc, int fr, int fq) const {
        const int row0 = u.pm * BM + wr * 64 + fr, col0 = u.pn * BM + wc * 32 + 4 * fq;
        float rsv[8];
        if constexpr (PLE_) {
#pragma unroll
            for (int g = 0; g < 8; ++g) rsv[g] = ss[row0 + (g >> 2) * HALF + (g & 3) * 16];
        }
        f32x4 hb_[2][4]; u32x2 pb_[2][4];
#define EPI_LOAD(g, slot) do { const size_t off_ = (size_t)(row0 + ((g) >> 2) * HALF + ((g) & 3) * 16) * DM + col0; \
        _Pragma("unroll") for (int q_ = 0; q_ < 4; ++q_) { const size_t o2_ = off_ + (q_ >> 1) * HALF + (q_ & 1) * 16; hb_[slot][q_] = *(const f32x4*)(Hin + o2_); if constexpr (PLE_) pb_[slot][q_] = *(const u32x2*)(PP + o2_); } } while (0)
        EPI_LOAD(0, 0);
#pragma unroll
        for (int g = 0; g < 8; ++g) {
            const int ai = g >> 2, m = g & 3, slot = g & 1;
            if (g + 1 < 8) { if (slot == 0) EPI_LOAD(g + 1, 1); else EPI_LOAD(g + 1, 0); }
            asm volatile("" ::: "memory");
            const int row = row0 + ai * HALF + m * 16; const size_t off = (size_t)row * DM + col0; float part = 0.f;
            float rs = 1.f; if constexpr (PLE_) rs = rsqrtf(rsv[g] * (1.0f / DM) + EPS);
#pragma unroll
            for (int q = 0; q < 4; ++q) {
                const int bj = q >> 1, n = q & 1; const size_t o2 = off + bj * HALF + n * 16;
                f32x4 hv = hb_[slot][q];
                if constexpr (PLE_) {
                    const u32x2 pw = pb_[slot][q]; const f32x4 pv = {bf_lo(pw.x), bf_hi(pw.x), bf_lo(pw.y), bf_hi(pw.y)};
#pragma unroll
                    for (int j = 0; j < 4; ++j) { const float a = acc[ai][bj][m][n][j] * rs; hv[j] += __builtin_amdgcn_rcpf(1.0f + __expf(-a)) * pv[j]; }
                } else hv += acc[ai][bj][m][n];
                *(f32x4*)(H + o2) = hv;
                u32x2 w; w.x = cvt_pk_bf16(hv[0], hv[1]); w.y = cvt_pk_bf16(hv[2], hv[3]); *(u32x2*)(HB + o2) = w;
                part += (hv[0] * hv[0] + hv[1] * hv[1]) + (hv[2] * hv[2] + hv[3] * hv[3]);
            }
            part += __shfl_xor(part, 16); part += __shfl_xor(part, 32); if (fq == 0) unsafeAtomicAdd(sso + row, part);
            asm volatile("" ::: "memory");
        }
#undef EPI_LOAD
    }
};
typedef EpiResT<false> EpiResid;
typedef EpiResT<true> EpiPle;

template <class Epi, class Sched>
__device__ __forceinline__ void gemm_phase(LAS unsigned char* lds, const Gemm g, const Sched& S, const Epi& E, int wv_) {
    int tid; { unsigned z_ = 0u; asm volatile("" : "+v"(z_)); tid = wv_ * 64 + (int)__builtin_amdgcn_mbcnt_hi(~0u, __builtin_amdgcn_mbcnt_lo(~0u, z_)); asm volatile("" : "+v"(tid)); }
    const int wid = __builtin_amdgcn_readfirstlane(tid >> 6), lane = tid & 63, wr = wid >> 2, wc = wid & 3, fr = lane & 15, fq = lane >> 4;
    const int K = g.K, nt = K / BK;
    unsigned voffA[2], voffB[2];
#pragma unroll
    for (int i = 0; i < 2; ++i) { int R, C; stage_rc(tid * 16 + i * 8192, R, C); const int Rb = Epi::PERM ? ((R & ~31) + perm32(R & 31)) : R;
        voffA[i] = (unsigned)(R * K + C) * 2u; voffB[i] = (unsigned)(Rb * K + C) * 2u; }
    const size_t kstep = (size_t)(BK * 2);
    const size_t hstep = (size_t)HALF * K * 2;
    const size_t tstep = 2 * hstep;
    const unsigned ldsw = (unsigned)wid * 1024u;
    const int aoff = lds_byte(wr * 64 + fr, fq * 8), boff = lds_byte(wc * 32 + fr, fq * 8);
#define PG8_SA(b, h) (((b) * 2 + (h)) * HTB)
#define PG8_SB(b, h) ((4 + (b) * 2 + (h)) * HTB)
#define PG8_STAGE(bufoff, gbase, voff) do { _Pragma("unroll") for (int _i = 0; _i < 2; ++_i) \
        __builtin_amdgcn_global_load_lds((const unsigned*)((const char*)(gbase) + (voff)[_i]), (LAS unsigned*)(lds + (bufoff) + ldsw + _i * 8192), 16, 0, 0); } while (0)
#define PG8_LDA(dst, b, h) do { _Pragma("unroll") for (int m = 0; m < 4; ++m) _Pragma("unroll") for (int k = 0; k < 2; ++k) dst[m][k] = *(const LAS bf16x8*)(lds + PG8_SA(b, h) + aoff + m * 2048 + k * 1024); } while (0)
#define PG8_LDB(dst, b, h) do { _Pragma("unroll") for (int n = 0; n < 2; ++n) _Pragma("unroll") for (int k = 0; k < 2; ++k) dst[n][k] = *(const LAS bf16x8*)(lds + PG8_SB(b, h) + boff + n * 2048 + k * 1024); } while (0)
#define PG8_MMA(ai, bj, At, Bt) do { __builtin_amdgcn_s_setprio(1); _Pragma("unroll") for (int m = 0; m < 4; ++m) _Pragma("unroll") for (int n = 0; n < 2; ++n) _Pragma("unroll") for (int k = 0; k < 2; ++k) \
        acc[ai][bj][m][n] = __builtin_amdgcn_mfma_f32_16x16x32_bf16(Bt[n][k], At[m][k], acc[ai][bj][m][n], 0, 0, 0); __builtin_amdgcn_s_setprio(0); } while (0)
#define PG8_WAIT_V(n) asm volatile("s_waitcnt vmcnt(" #n ")" ::: "memory")
#define PG8_WAIT_L(n) asm volatile("s_waitcnt lgkmcnt(" #n ")" ::: "memory")
#define PG8_BAR __builtin_amdgcn_s_barrier()
#define PG8_SCHED __builtin_amdgcn_sched_barrier(0)
    Unit cur, nxt; int ui = 0;
    if (!S.next(0, cur)) return;
    f32x4 acc[2][2][4][2];
#pragma unroll
    for (int a = 0; a < 2; ++a)
#pragma unroll
        for (int b = 0; b < 2; ++b)
#pragma unroll
            for (int m = 0; m < 4; ++m)
#pragma unroll
                for (int n = 0; n < 2; ++n) acc[a][b][m][n] = (f32x4){0.f, 0.f, 0.f, 0.f};
    bf16x8 At[4][2], B0[2][2], B1[2][2];
    const char* cA = (const char*)g.A + (size_t)cur.pm * tstep; const char* cB = (const char*)g.Bt + (size_t)cur.pn * tstep;
    S.a_ready(cur);
    PG8_STAGE(PG8_SB(0, 0), cB, voffB); PG8_STAGE(PG8_SA(0, 0), cA, voffA); PG8_STAGE(PG8_SB(0, 1), cB + hstep, voffB); PG8_STAGE(PG8_SA(0, 1), cA + hstep, voffA);
    if (wr == 1) PG8_BAR;
    PG8_WAIT_V(4); PG8_BAR;
    PG8_STAGE(PG8_SB(1, 0), cB + kstep, voffB); PG8_STAGE(PG8_SA(1, 0), cA + kstep, voffA); PG8_STAGE(PG8_SB(1, 1), cB + hstep + kstep, voffB);
    PG8_WAIT_V(6); PG8_BAR;
    for (;;) {
        const bool has_next = S.next(ui + 1, nxt);
        const char* nA = has_next ? (const char*)g.A + (size_t)nxt.pm * tstep : cA; const char* nB = has_next ? (const char*)g.Bt + (size_t)nxt.pn * tstep : cB;
        for (int t = 0; t < nt; t += 2) {
            const bool last = (t == nt - 2);
            const char* a1 = cA + (size_t)(t + 1) * kstep;
            const char* a2 = last ? nA : cA + (size_t)(t + 2) * kstep; const char* b2 = last ? nB : cB + (size_t)(t + 2) * kstep;
            const char* a3 = a2 + kstep; const char* b3 = b2 + kstep;
            if (last && has_next) S.a_ready(nxt);
            PG8_LDB(B0, 0, 0); PG8_SCHED; PG8_LDA(At, 0, 0); PG8_STAGE(PG8_SA(1, 1), a1 + hstep, voffA);
            PG8_WAIT_L(8); PG8_BAR; PG8_WAIT_L(0); PG8_MMA(0, 0, At, B0); PG8_BAR; PG8_SCHED;
            PG8_LDB(B1, 0, 1); PG8_STAGE(PG8_SB(0, 0), b2, voffB);
            PG8_BAR; PG8_WAIT_L(0); PG8_MMA(0, 1, At, B1); PG8_BAR;
            PG8_LDA(At, 0, 1); PG8_STAGE(PG8_SA(0, 0), a2, voffA);
            PG8_BAR; PG8_WAIT_L(0); PG8_MMA(1, 0, At, B0); PG8_BAR; PG8_SCHED;
            PG8_STAGE(PG8_SB(0, 1), b2 + hstep, voffB);
            PG8_WAIT_V(6); PG8_BAR; PG8_MMA(1, 1, At, B1); PG8_BAR;
            PG8_LDB(B0, 1, 0); PG8_SCHED; PG8_LDA(At, 1, 0); PG8_STAGE(PG8_SA(0, 1), a2 + hstep, voffA);
            PG8_WAIT_L(8); PG8_BAR; PG8_WAIT_L(0); PG8_MMA(0, 0, At, B0); PG8_BAR; PG8_SCHED;
            PG8_LDB(B1, 1, 1); PG8_STAGE(PG8_SB(1, 0), b3, voffB);
            PG8_BAR; PG8_WAIT_L(0); PG8_MMA(0, 1, At, B1); PG8_BAR;
            PG8_LDA(At, 1, 1); PG8_STAGE(PG8_SA(1, 0), a3, voffA);
            PG8_BAR; PG8_WAIT_L(0); PG8_MMA(1, 0, At, B0); PG8_BAR; PG8_SCHED;
            PG8_STAGE(PG8_SB(1, 1), b3 + hstep, voffB);
            PG8_WAIT_V(6); PG8_BAR; PG8_MMA(1, 1, At, B1); PG8_BAR;
        }
        E(acc, cur, wr, wc, fr, fq); S.done(cur);
        if (!has_next) break;
#pragma unroll
        for (int a = 0; a < 2; ++a)
#pragma unroll
            for (int b = 0; b < 2; ++b)
#pragma unroll
                for (int m = 0; m < 4; ++m)
#pragma unroll
                    for (int n = 0; n < 2; ++n) acc[a][b][m][n] = (f32x4){0.f, 0.f, 0.f, 0.f};
        cur = nxt; cA = nA; cB = nB; ++ui;
    }
    PG8_WAIT_V(0);
    if (wr == 0) PG8_BAR;
    PG8_BAR;
#undef PG8_SA
#undef PG8_SB
#undef PG8_STAGE
#undef PG8_LDA
#undef PG8_LDB
#undef PG8_MMA
#undef PG8_WAIT_V
#undef PG8_WAIT_L
#undef PG8_BAR
#undef PG8_SCHED
}
}

template <class Epi>
__device__ __forceinline__ void run_gemm(LAS unsigned char* lds, const bf16_t* A, const bf16_t* Bt, int N, int K, const Epi& E, int wv_) {
    int G_ = (int)gridDim.x, c_ = (int)blockIdx.x; asm volatile("" : "+s"(G_), "+s"(c_));
    pg8::Gemm g{A, Bt, SEQ, N, K}; pg8::StaticOrder S; S.init(SEQ, N, G_, c_);
#ifndef NO_GEMM
    pg8::gemm_phase<Epi, pg8::StaticOrder>(lds, g, S, E, wv_);
#endif
}

namespace att {
constexpr int KVBLK = 64;
constexpr int SHM_V = KVBLK * 128 * 2;
#define SBAR() __builtin_amdgcn_sched_barrier(0)
__device__ __forceinline__ int crow(int r, int hi) { return (r & 3) + 8 * (r >> 2) + 4 * hi; }
template <int DQ> __device__ __forceinline__ int kswz(int row, int colB) { return row * (DQ * 2) + (colB ^ ((DQ == 128 ? (row & 15) : ((row >> 1) & 7)) << 4)); }

template <int DQ>
__device__ __forceinline__ void partialSM(f32x16& p0, f32x16& p1, float& m_reg, float& mn, float& alpha) {
    constexpr float SCALE = DQ == 128 ? 0.088388347648318440f : 0.072168783648703220f;
    constexpr float THR = 8.f;
    constexpr float C = SCALE * 1.4426950408889634f;
    float pmax = p0[0];
#pragma unroll
    for (int r = 1; r < 16; ++r) pmax = fmaxf(pmax, p0[r]);
#pragma unroll
    for (int r = 0; r < 16; ++r) pmax = fmaxf(pmax, p1[r]);
    { auto rr = __builtin_amdgcn_permlane32_swap(__float_as_uint(pmax), __float_as_uint(pmax), false, false);
      pmax = fmaxf(__uint_as_float(rr[0]), __uint_as_float(rr[1])); }
    if (__builtin_expect(__all(pmax - m_reg <= THR / SCALE), 1)) { mn = m_reg; alpha = 1.f; }
    else { mn = fmaxf(m_reg, pmax); alpha = __builtin_amdgcn_exp2f((m_reg - mn) * C); m_reg = mn; }
    const float mnC = -mn * C;
#pragma unroll
    for (int r = 0; r < 16; ++r) p0[r] = fmaf(p0[r], C, mnC);
#pragma unroll
    for (int r = 0; r < 16; ++r) p1[r] = fmaf(p1[r], C, mnC);
#pragma unroll
    for (int r = 0; r < 16; ++r) p0[r] = __builtin_amdgcn_exp2f(p0[r]);
}
__device__ __forceinline__ void finishSM(f32x16& p0, f32x16& p1, float alpha, float& l_reg, bf16x8& pa0, bf16x8& pa1, bf16x8& pa2, bf16x8& pa3) {
#pragma unroll
    for (int r = 0; r < 16; ++r) p1[r] = __builtin_amdgcn_exp2f(p1[r]);
    float ps = 0;
#pragma unroll
    for (int r = 0; r < 16; ++r) ps += p0[r];
#pragma unroll
    for (int r = 0; r < 16; ++r) ps += p1[r];
    { auto rr = __builtin_amdgcn_permlane32_swap(__float_as_uint(ps), __float_as_uint(ps), false, false);
      ps = __uint_as_float(rr[0]) + __uint_as_float(rr[1]); }
    l_reg = l_reg * alpha + ps;
#define PK4(P, BASE, OUT) do { unsigned a0 = cvt_pk_bf16(P[BASE + 0], P[BASE + 1]), a1 = cvt_pk_bf16(P[BASE + 2], P[BASE + 3]);   \
    unsigned b0 = cvt_pk_bf16(P[BASE + 4], P[BASE + 5]), b1 = cvt_pk_bf16(P[BASE + 6], P[BASE + 7]);                              \
    auto r0 = __builtin_amdgcn_permlane32_swap(a0, b0, false, false); auto r1 = __builtin_amdgcn_permlane32_swap(a1, b1, false, false); \
    u32x4 w = {r0[0], r1[0], r0[1], r1[1]}; OUT = *reinterpret_cast<bf16x8*>(&w); } while (0)
    PK4(p0, 0, pa0); PK4(p0, 8, pa1); PK4(p1, 0, pa2); PK4(p1, 8, pa3);
#undef PK4
}
template <int DQ, int NQR>
__device__ __forceinline__ void qkt(f32x16& p0, f32x16& p1, const char* Ks, const bf16x8* qr, const char* Qs, int r32, int hi) {
    p0 = f32x16{}; p1 = f32x16{};
#pragma unroll
    for (int d0 = 0; d0 < DQ / 16; ++d0) { const int cb = (d0 * 16 + hi * 8) * 2;
        bf16x8 b0 = *reinterpret_cast<const bf16x8*>(Ks + kswz<DQ>(r32, cb));
        bf16x8 b1 = *reinterpret_cast<const bf16x8*>(Ks + kswz<DQ>(32 + r32, cb));
        bf16x8 q;
        if (d0 < NQR) q = qr[d0 < NQR ? d0 : 0]; else q = *reinterpret_cast<const bf16x8*>(Qs + (d0 - NQR) * 1024);
        p0 = __builtin_amdgcn_mfma_f32_32x32x16_bf16(b0, q, p0, 0, 0, 0);
        p1 = __builtin_amdgcn_mfma_f32_32x32x16_bf16(b1, q, p1, 0, 0, 0); }
}
__device__ __forceinline__ void band_mask(f32x16& p0, f32x16& p1, int kb, int qp, int hw, int Lc, int hi) {
    const float NINF = -__builtin_inff();
#pragma unroll
    for (int r = 0; r < 16; ++r) {
        const int kp0 = kb + crow(r, hi), kp1 = kp0 + 32;
        const bool ok0 = ((unsigned)(kp0 - qp + hw) <= (unsigned)(2 * hw)) && ((unsigned)kp0 < (unsigned)Lc);
        const bool ok1 = ((unsigned)(kp1 - qp + hw) <= (unsigned)(2 * hw)) && ((unsigned)kp1 < (unsigned)Lc);
        p0[r] = ok0 ? p0[r] : NINF; p1[r] = ok1 ? p1[r] : NINF;
    }
}
__device__ __forceinline__ int v_st(int k, int c) { const int kk = (k & ~0xC) | ((k & 4) << 1) | ((k & 8) >> 1); return ((kk >> 3) * 4 + (c >> 5)) * 512 + ((kk & 7) * 32 + (c & 31)) * 2; }
__device__ __forceinline__ int v_rd_base(int lane) { return ((lane & 3) << 3) | (((lane >> 2) & 3) << 6) | (((lane >> 4) & 1) << 5) | (((lane >> 5) & 1) << 8); }
constexpr int v_rd_off(int d0, int ks, int half) { return d0 * 512 + ks * 4096 + half * 2048; }
template <int OFF> __device__ __forceinline__ s16x4 tr_read(int vb) {
    s16x4 r; asm volatile("ds_read_b64_tr_b16 %0, %1 offset:%2" : "=&v"(r) : "v"(vb), "i"(OFF) : "memory"); return r;
}
template <int D0> __device__ __forceinline__ void pv_one(f32x16& od, int vb, bf16x8 pa0, bf16x8 pa1, bf16x8 pa2, bf16x8 pa3) {
    const s16x4 l0 = tr_read<v_rd_off(D0, 0, 0)>(vb), h0 = tr_read<v_rd_off(D0, 0, 1)>(vb), l1 = tr_read<v_rd_off(D0, 1, 0)>(vb), h1 = tr_read<v_rd_off(D0, 1, 1)>(vb);
    const s16x4 l2 = tr_read<v_rd_off(D0, 2, 0)>(vb), h2 = tr_read<v_rd_off(D0, 2, 1)>(vb), l3 = tr_read<v_rd_off(D0, 3, 0)>(vb), h3 = tr_read<v_rd_off(D0, 3, 1)>(vb);
    asm volatile("s_waitcnt lgkmcnt(0)" ::: "memory"); SBAR();
#define PK(L, H) (bf16x8){L[0], L[1], L[2], L[3], H[0], H[1], H[2], H[3]}
    od = __builtin_amdgcn_mfma_f32_32x32x16_bf16(pa0, PK(l0, h0), od, 0, 0, 0);
    od = __builtin_amdgcn_mfma_f32_32x32x16_bf16(pa1, PK(l1, h1), od, 0, 0, 0);
    od = __builtin_amdgcn_mfma_f32_32x32x16_bf16(pa2, PK(l2, h2), od, 0, 0, 0);
    od = __builtin_amdgcn_mfma_f32_32x32x16_bf16(pa3, PK(l3, h3), od, 0, 0, 0);
#undef PK
}
__device__ __forceinline__ void pv_d0(f32x16* o, int vb, bf16x8 pa0, bf16x8 pa1, bf16x8 pa2, bf16x8 pa3) {
    pv_one<0>(o[0], vb, pa0, pa1, pa2, pa3); pv_one<1>(o[1], vb, pa0, pa1, pa2, pa3); pv_one<2>(o[2], vb, pa0, pa1, pa2, pa3); pv_one<3>(o[3], vb, pa0, pa1, pa2, pa3);
}

template <int DQ, int MODE, int SDEPTH>
__device__ __forceinline__ void attn_body(const bf16_t* __restrict__ Qb, long ldq, const bf16_t* __restrict__ Kh, long ldk, const bf16_t* __restrict__ Vh, long ldv,
                                          bf16_t* __restrict__ Ob, long ldo, float* __restrict__ lse_out, long ldl,
                                          int q0, int kt0, int NT, int Lc, int hw, float sink, char* lds, int wv_) {
    constexpr int SHM_K = KVBLK * DQ * 2;
    constexpr float SCALE = DQ == 128 ? 0.088388347648318440f : 0.072168783648703220f;
    constexpr float C = SCALE * 1.4426950408889634f;
    int tid; { unsigned z_ = 0u; asm volatile("" : "+v"(z_)); tid = wv_ * 64 + (int)__builtin_amdgcn_mbcnt_hi(~0u, __builtin_amdgcn_mbcnt_lo(~0u, z_)); asm volatile("" : "+v"(tid)); }
    const int wid = tid >> 6, lane = tid & 63, r32 = lane & 31, hi = lane >> 5;
    char* V_lds = lds; char* K_lds = lds + 2 * SHM_V;
    float* ws = (float*)(lds + 2 * SHM_V + 2 * SHM_K) + wid * 64; float* li_l = ws; float* al_l = ws + 32;
    constexpr int NQR = (DQ == 192) ? 8 : (MODE == 0 ? 8 : 4);
    float m_reg = -1e30f, l_reg = 0; f32x16 o[4] = {}; bf16x8 qr[NQR];
    const int qp = q0 + wid * 32 + r32;
    const bf16_t* Qw = Qb + (long)qp * ldq + hi * 8;
    char* Qs = lds + 2 * SHM_V + 2 * SHM_K + 2048 + wid * 4096 + lane * 16;
#pragma unroll
    for (int d0 = 0; d0 < NQR; ++d0) qr[d0] = *reinterpret_cast<const bf16x8*>(Qw + d0 * 16);
    bf16x8 qpark[DQ / 16 - NQR];
#pragma unroll
    for (int d0 = NQR; d0 < DQ / 16; ++d0) qpark[d0 - NQR] = *reinterpret_cast<const bf16x8*>(Qw + d0 * 16);
    const int sr = tid >> 4, sc = (tid & 15) * 8, vst0 = v_st(sr, sc), vst1 = v_st(32 + sr, sc);
    const int sr2 = tid >> 3, sc2 = 128 + (tid & 7) * 8;
    const int vb0 = (int)(uintptr_t)V_lds + v_rd_base(lane);
    struct { bf16x8 vs0, vs1, ks0, ks1, ks2; } sr_[SDEPTH];
#define CLAMPR(x) ((x) < 0 ? 0 : ((x) >= Lc ? Lc - 1 : (x)))
#define SLOAD(i, kb) do { const long ra = CLAMPR((kb) + sr), rb = CLAMPR((kb) + 32 + sr); \
    sr_[i].vs0 = *reinterpret_cast<const bf16x8*>(Vh + ra * ldv + sc); sr_[i].vs1 = *reinterpret_cast<const bf16x8*>(Vh + rb * ldv + sc); \
    sr_[i].ks0 = *reinterpret_cast<const bf16x8*>(Kh + ra * ldk + sc); sr_[i].ks1 = *reinterpret_cast<const bf16x8*>(Kh + rb * ldk + sc); \
    if constexpr (DQ == 192) { const long rc = CLAMPR((kb) + sr2); sr_[i].ks2 = *reinterpret_cast<const bf16x8*>(Kh + rc * ldk + sc2); } } while (0)
#define SWRITE(b, i) do { *(bf16x8*)(V_lds + (b) * SHM_V + vst0) = sr_[i].vs0; *(bf16x8*)(V_lds + (b) * SHM_V + vst1) = sr_[i].vs1; \
    *(bf16x8*)(K_lds + (b) * SHM_K + kswz<DQ>(sr, sc * 2)) = sr_[i].ks0; *(bf16x8*)(K_lds + (b) * SHM_K + kswz<DQ>(32 + sr, sc * 2)) = sr_[i].ks1; \
    if constexpr (DQ == 192) { *(bf16x8*)(K_lds + (b) * SHM_K + kswz<DQ>(sr2, sc2 * 2)) = sr_[i].ks2; } } while (0)
#define SWAIT() do { if constexpr (SDEPTH == 2) { if constexpr (DQ == 192) asm volatile("s_waitcnt vmcnt(5)" ::: "memory"); else asm volatile("s_waitcnt vmcnt(4)" ::: "memory"); } else asm volatile("s_waitcnt vmcnt(0)" ::: "memory"); } while (0)
#define RESC(a) do { if (__any((a) < 1.f)) { if (hi == 0) al_l[r32] = (a); asm volatile("s_waitcnt lgkmcnt(0)" ::: "memory"); \
    _Pragma("unroll") for (int d = 0; d < 4; ++d) _Pragma("unroll") for (int r = 0; r < 16; ++r) o[d][r] *= al_l[crow(r, hi)]; } } while (0)
#define MASK(P0, P1, j) do { if constexpr (MODE != 0) band_mask(P0, P1, kt0 + (j) * KVBLK, qp, hw, Lc, hi); } while (0)
    f32x16 pA0, pA1, pB0, pB1; float mnA, mnB, alA = 1.f, alB = 1.f;
    constexpr int SE = 0, SO = SDEPTH - 1;
    const int wq = __builtin_amdgcn_readfirstlane(wid) * 32;
    const int jlo = MODE == 0 ? 0 : (wq >= 64 ? (wq - 63 + 63) / 64 : 0), jhi = MODE == 0 ? 0x7fffffff : (wq + 31 + 2 * hw) / 64;
#define REL(j) (MODE == 0 ? true : ((j) >= jlo && (j) <= jhi))
    bool relA = REL(0), relB;
    SLOAD(SE, kt0);
#pragma unroll
    for (int d0 = NQR; d0 < DQ / 16; ++d0) *reinterpret_cast<bf16x8*>(Qs + (d0 - NQR) * 1024) = qpark[d0 - NQR];
    asm volatile("s_waitcnt vmcnt(0)" ::: "memory"); SWRITE(0, SE); __syncthreads();
    if (relA) { qkt<DQ, NQR>(pA0, pA1, K_lds, qr, Qs, r32, hi); MASK(pA0, pA1, 0); partialSM<DQ>(pA0, pA1, m_reg, mnA, alA); }
    SLOAD(SO, kt0 + KVBLK); if constexpr (SDEPTH == 2) { if (2 < NT) SLOAD(SE, kt0 + 2 * KVBLK); }
    SWAIT(); SWRITE(1, SO); __syncthreads();
    for (int j = 1; j + 1 < NT; j += 2) {
        relB = REL(j);
        SBAR(); if (relB) qkt<DQ, NQR>(pB0, pB1, K_lds + SHM_K, qr, Qs, r32, hi);
        SBAR(); SLOAD(SO, kt0 + (j + SDEPTH) * KVBLK); SBAR();
        if (relA) { bf16x8 pa0, pa1, pa2, pa3; finishSM(pA0, pA1, alA, l_reg, pa0, pa1, pa2, pa3); SBAR(); pv_d0(o, vb0, pa0, pa1, pa2, pa3); }
        alB = 1.f; if (relB) { MASK(pB0, pB1, j); partialSM<DQ>(pB0, pB1, m_reg, mnB, alB); }
        __syncthreads(); SWAIT(); SWRITE(0, SE);
        RESC(alB); __syncthreads();
        relA = REL(j + 1);
        SBAR(); if (relA) qkt<DQ, NQR>(pA0, pA1, K_lds, qr, Qs, r32, hi);
        SBAR(); if (SDEPTH == 1 || j + 3 < NT) SLOAD(SE, kt0 + (j + 1 + SDEPTH) * KVBLK); SBAR();
        if (relB) { bf16x8 pa0, pa1, pa2, pa3; finishSM(pB0, pB1, alB, l_reg, pa0, pa1, pa2, pa3); SBAR(); pv_d0(o, vb0 + SHM_V, pa0, pa1, pa2, pa3); }
        alA = 1.f; if (relA) { MASK(pA0, pA1, j + 1); partialSM<DQ>(pA0, pA1, m_reg, mnA, alA); }
        __syncthreads(); SWAIT(); SWRITE(1, SO);
        RESC(alA); __syncthreads();
    }
    relB = REL(NT - 1);
    SBAR(); if (relB) qkt<DQ, NQR>(pB0, pB1, K_lds + SHM_K, qr, Qs, r32, hi);
    if (relA) { bf16x8 pa0, pa1, pa2, pa3; finishSM(pA0, pA1, alA, l_reg, pa0, pa1, pa2, pa3); SBAR(); pv_d0(o, vb0, pa0, pa1, pa2, pa3); }
    alB = 1.f; if (relB) { MASK(pB0, pB1, NT - 1); partialSM<DQ>(pB0, pB1, m_reg, mnB, alB); }
    __syncthreads(); RESC(alB);
    if (relB) { bf16x8 pa0, pa1, pa2, pa3; finishSM(pB0, pB1, alB, l_reg, pa0, pa1, pa2, pa3); SBAR();
                pv_d0(o, vb0 + SHM_V, pa0, pa1, pa2, pa3); }
#undef REL
    if constexpr (MODE == 1) l_reg += __builtin_amdgcn_exp2f(sink * 1.4426950408889634f - m_reg * C);
    int q0e = q0; asm volatile("" : "+s"(q0e));
    if constexpr (MODE == 2) { if (hi == 0) lse_out[(long)(q0e + wid * 32 + r32) * ldl] = (m_reg * C + __builtin_amdgcn_logf(l_reg)) * 0.6931471805599453f; }
    if (hi == 0) li_l[r32] = l_reg; asm volatile("s_waitcnt lgkmcnt(0)" ::: "memory");
    float rli[16];
#pragma unroll
    for (int r = 0; r < 16; ++r) rli[r] = __builtin_amdgcn_rcpf(li_l[crow(r, hi)]);
    bf16_t* Ow = Ob + (long)(q0e + wid * 32) * ldo;
#pragma unroll
    for (int r = 0; r < 16; ++r) { const int orow = crow(r, hi);
#pragma unroll
        for (int d0 = 0; d0 < 4; ++d0) Ow[(long)orow * ldo + d0 * 32 + r32] = (bf16_t)(cvt_pk_bf16(o[d0][r] * rli[r], 0.f) & 0xffffu); }
    __syncthreads();
#undef CLAMPR
#undef SLOAD
#undef SWRITE
#undef SWAIT
#undef RESC
#undef MASK
}
}

__device__ __forceinline__ unsigned char* ws_fresh() {
    unsigned off = (unsigned)offsetof(Args, ws); asm volatile("" : "+s"(off));
    const __attribute__((address_space(4))) char* k = (const __attribute__((address_space(4))) char*)__builtin_amdgcn_kernarg_segment_ptr();
    return *(unsigned char* const __attribute__((address_space(4)))*)(k + off);
}
__device__ __forceinline__ void weight_tiles(const Args& a, LAS unsigned char* lds, int wv_, int t_first, int t_end, int stride, int j0) {
    int tid; { unsigned z_ = 0u; asm volatile("" : "+v"(z_)); tid = wv_ * 64 + (int)__builtin_amdgcn_mbcnt_hi(~0u, __builtin_amdgcn_mbcnt_lo(~0u, z_)); asm volatile("" : "+v"(tid)); }
    LAS unsigned* L = (LAS unsigned*)lds;
    const int c = tid & 15, nr = tid >> 4, n4 = (tid & 15) * 4, kp = tid >> 4;
    int j = j0;
    unsigned char* wsl = ws_fresh();
    for (int t0 = t_first; t0 < t_end; t0 += 2 * stride) {
        f32x4 r0[2][2], r1[2][2]; float g0[2][2], g1[2][2]; bf16_t* dst[2]; int Kc[2]; bool live[2];
#pragma unroll
        for (int u = 0; u < 2; ++u) {
            const int t = t0 + u * stride; live[u] = t < t_end; dst[u] = nullptr; Kc[u] = 0;
            if (live[u]) {
                while (t >= a.tile_start[j + 1]) ++j;
                const float* src = a.jobs[j].src; const float* gain = a.jobs[j].gain; const int K = a.jobs[j].K, N = a.jobs[j].N, Npad = a.jobs[j].Npad, blk = a.jobs[j].blk;
                const int lt = t - a.tile_start[j], ntn = Npad / 64, kt = lt / ntn, ntile = lt - kt * ntn, k0 = kt * 128, n0 = ntile * 64;
                const int drow0 = (n0 / blk) * a.jobs[j].blkstride + a.jobs[j].boff + (n0 % blk);
                dst[u] = (bf16_t*)(wsl + a.jobs[j].dst_off) + (size_t)drow0 * K + k0; Kc[u] = K;
#pragma unroll
                for (int i = 0; i < 2; ++i) { const int k = k0 + 2 * kp + 64 * i;
                    if (n0 < N) { r0[u][i] = *(const f32x4*)(src + (size_t)k * N + n0 + n4); r1[u][i] = *(const f32x4*)(src + (size_t)(k + 1) * N + n0 + n4); g0[u][i] = gain ? gain[k] : 1.f; g1[u][i] = gain ? gain[k + 1] : 1.f; }
                    else { r0[u][i] = (f32x4){0.f, 0.f, 0.f, 0.f}; r1[u][i] = r0[u][i]; g0[u][i] = 0.f; g1[u][i] = 0.f; } }
            }
        }
#pragma unroll
        for (int u = 0; u < 2; ++u) if (live[u]) {
#pragma unroll
            for (int i = 0; i < 2; ++i)
#pragma unroll
                for (int jj = 0; jj < 4; ++jj) L[u * 4160 + (n4 + jj) * 65 + kp + 32 * i] = cvt_pk_bf16(r0[u][i][jj] * g0[u][i], r1[u][i][jj] * g1[u][i]);
        }
        __syncthreads();
#pragma unroll
        for (int u = 0; u < 2; ++u) if (live[u]) {
#pragma unroll
            for (int i = 0; i < 2; ++i) { const int n = nr + 32 * i; const LAS unsigned* Lr = L + u * 4160 + n * 65 + 4 * c; u32x4 w; w.x = Lr[0]; w.y = Lr[1]; w.z = Lr[2]; w.w = Lr[3];
                *(u32x4*)(dst[u] + (size_t)n * Kc[u] + 8 * c) = w; }
        }
        __syncthreads();
    }
}
__device__ __forceinline__ void prep_phase(const Args& a, LAS unsigned char* lds, int wv_) {
    weight_tiles(a, lds, wv_, (int)blockIdx.x, a.tile_start[NJOBS_MAIN], (int)gridDim.x, 0);
    int tid; { unsigned z_ = 0u; asm volatile("" : "+v"(z_)); tid = wv_ * 64 + (int)__builtin_amdgcn_mbcnt_hi(~0u, __builtin_amdgcn_mbcnt_lo(~0u, z_)); asm volatile("" : "+v"(tid)); }
    const int G = gridDim.x, wid = tid >> 6, lane = tid & 63;
    unsigned char* wsl = ws_fresh();
    const float* x = a.in[0]; bf16_t* hb = (bf16_t*)(wsl + OFF_HB); float* ss = (float*)(wsl + OFF_SS);
    for (int row = blockIdx.x * 8 + wid; row < SEQ; row += G * 8) {
        float s = 0.f;
#pragma unroll
        for (int i = 0; i < 8; ++i) { const size_t o2 = (size_t)row * DM + (i * 64 + lane) * 4; const f32x4 v = *(const f32x4*)(x + o2);
            u32x2 w; w.x = cvt_pk_bf16(v[0], v[1]); w.y = cvt_pk_bf16(v[2], v[3]); *(u32x2*)(hb + o2) = w; s += (v[0] * v[0] + v[1] * v[1]) + (v[2] * v[2] + v[3] * v[3]); }
#pragma unroll
        for (int o = 32; o >= 1; o >>= 1) s += __shfl_xor(s, o);
        if (lane == 0) ss[row] = s;
    }
    for (int i = blockIdx.x * 512 + tid; i < 15 * SEQ; i += G * 512) ss[SEQ + i] = 0.f;
    { const float* p = a.in[1]; bf16_t* pb = (bf16_t*)(wsl + OFF_PBF);
      for (size_t i = (size_t)blockIdx.x * 512 + tid; i < (size_t)NLAYER * SEQ * PLE / 8; i += (size_t)G * 512) {
          const f32x4 v0 = *(const f32x4*)(p + i * 8), v1 = *(const f32x4*)(p + i * 8 + 4);
          u32x4 w; w.x = cvt_pk_bf16(v0[0], v0[1]); w.y = cvt_pk_bf16(v0[2], v0[3]); w.z = cvt_pk_bf16(v1[0], v1[1]); w.w = cvt_pk_bf16(v1[2], v1[3]); *(u32x4*)(pb + i * 8) = w; } }
    { const int* pos = (const int*)a.in[2]; f32x2* r32t = (f32x2*)(wsl + OFF_R32); f32x2* r64t = (f32x2*)(wsl + OFF_R64);
      for (int i = blockIdx.x * 512 + tid; i < SEQ * 48; i += G * 512) {
          const int tok = i / 48, f = i - tok * 48;
          const double inv = f < 16 ? a.inv32[f < 16 ? f : 0] : a.inv64[f < 16 ? 0 : f - 16];
          double tt = (double)pos[tok] * inv * 0.15915494309189533577; tt -= rint(tt);
          const float tf = (float)tt; f32x2 cs; cs.x = __builtin_amdgcn_cosf(tf); cs.y = __builtin_amdgcn_sinf(tf);
          if (f < 16) r32t[tok * 16 + f] = cs; else r64t[tok * 32 + (f - 16)] = cs; } }
}

__device__ __forceinline__ void post_hd128(bf16_t* buf, int ld, int nh, int nq, const float* gq, const float* gk, const f32x2* rope, int wv_) {
    int tid; { unsigned z_ = 0u; asm volatile("" : "+v"(z_)); tid = wv_ * 64 + (int)__builtin_amdgcn_mbcnt_hi(~0u, __builtin_amdgcn_mbcnt_lo(~0u, z_)); asm volatile("" : "+v"(tid)); }
    const int sub = tid & 15;
    const int npairs = SEQ * nh, step = (int)gridDim.x * 32;
    for (int p0 = (int)blockIdx.x * 32 + (tid >> 4); p0 < npairs; p0 += 4 * step) {
        u32x4 w[4]; bf16_t* ptr[4]; int tok[4], hd[4];
#pragma unroll
        for (int u = 0; u < 4; ++u) { const int p = p0 + u * step; const bool ok = p < npairs; const unsigned pp = (unsigned)(ok ? p : p0); tok[u] = (int)(pp / (unsigned)nh); hd[u] = (int)(pp - (unsigned)tok[u] * (unsigned)nh);
            ptr[u] = buf + (size_t)tok[u] * ld + hd[u] * 128 + sub * 8; w[u] = *(const u32x4*)ptr[u]; }
#pragma unroll
        for (int u = 0; u < 4; ++u) {
            float x[8]; unpack8(w[u], x);
            float s = 0.f;
#pragma unroll
            for (int j = 0; j < 8; ++j) s += x[j] * x[j];
            s += __shfl_xor(s, 1); s += __shfl_xor(s, 2); s += __shfl_xor(s, 4); s += __shfl_xor(s, 8);
            const float rstd = rsqrtf(s * (1.0f / 128.0f) + EPS);
            const float* g = (hd[u] < nq ? gq : gk) + sub * 8;
            float y[8], yp[8];
#pragma unroll
            for (int j = 0; j < 8; ++j) y[j] = x[j] * rstd * g[j];
#pragma unroll
            for (int j = 0; j < 8; ++j) yp[j] = __shfl_xor(y[j], 2);
            if (sub < 4) {
                const f32x2* cs = rope + (size_t)tok[u] * 16 + (sub & 1) * 8;
#pragma unroll
                for (int j = 0; j < 8; ++j) { const f32x2 c = cs[j]; y[j] = (sub < 2) ? (y[j] * c.x - yp[j] * c.y) : (y[j] * c.x + yp[j] * c.y); }
            }
            if (p0 + u * step < npairs) *(u32x4*)ptr[u] = pack8(y);
        }
    }
}
__device__ __forceinline__ void post_b(bf16_t* qraw, const bf16_t* kvraw, const bf16_t* krope, bf16_t* Kb, const float* gq, const float* gk, const f32x2* rope, int wv_) {
    int tid; { unsigned z_ = 0u; asm volatile("" : "+v"(z_)); tid = wv_ * 64 + (int)__builtin_amdgcn_mbcnt_hi(~0u, __builtin_amdgcn_mbcnt_lo(~0u, z_)); asm volatile("" : "+v"(tid)); }
    const int sub = tid & 31;
    const bool act = sub < 24, isrope = (sub >= 16) && act;
    const int npairs = SEQ * 16, step = (int)gridDim.x * 16;
    for (int p0 = (int)blockIdx.x * 16 + (tid >> 5); p0 < npairs; p0 += 2 * step) {
        u32x4 w[2][2]; int tok[2], hd[2];
#pragma unroll
        for (int u = 0; u < 2; ++u) { const int p = (p0 + u * step < npairs) ? p0 + u * step : p0; tok[u] = (p >> 4); hd[u] = (p & 15);
            w[u][0] = (u32x4){0u, 0u, 0u, 0u}; w[u][1] = (u32x4){0u, 0u, 0u, 0u};
            if (act) w[u][0] = *(const u32x4*)(qraw + (size_t)tok[u] * 3072 + hd[u] * 192 + sub * 8);
            if (sub < 16) w[u][1] = *(const u32x4*)(kvraw + (size_t)tok[u] * 4096 + hd[u] * 256 + sub * 8); else if (act) w[u][1] = *(const u32x4*)(krope + (size_t)tok[u] * 512 + (sub - 16) * 8); }
#pragma unroll
        for (int u = 0; u < 2; ++u) {
            const f32x2* cs = rope + (size_t)tok[u] * 32 + (sub & 3) * 8;
#pragma unroll
            for (int which = 0; which < 2; ++which) {
                float x[8]; unpack8(w[u][which], x);
                float s = 0.f;
#pragma unroll
                for (int j = 0; j < 8; ++j) s += x[j] * x[j];
                s += __shfl_xor(s, 1); s += __shfl_xor(s, 2); s += __shfl_xor(s, 4); s += __shfl_xor(s, 8); s += __shfl_xor(s, 16);
                const float rstd = rsqrtf(s * (1.0f / 192.0f) + EPS);
                const float* g = (which == 0 ? gq : gk) + (act ? sub * 8 : 0);
                float y[8], yp[8];
#pragma unroll
                for (int j = 0; j < 8; ++j) y[j] = x[j] * rstd * g[j];
#pragma unroll
                for (int j = 0; j < 8; ++j) yp[j] = __shfl_xor(y[j], 4);
                if (isrope) {
#pragma unroll
                    for (int j = 0; j < 8; ++j) { const f32x2 c = cs[j]; y[j] = (sub < 20) ? (y[j] * c.x - yp[j] * c.y) : (y[j] * c.x + yp[j] * c.y); }
                }
                if (act && (p0 + u * step < npairs)) { bf16_t* d = (which == 0 ? qraw : Kb) + (size_t)tok[u] * 3072 + hd[u] * 192 + sub * 8; *(u32x4*)d = pack8(y); }
            }
        }
    }
}
__device__ __forceinline__ void merge_c(const bf16_t* og, const float* lse, bf16_t* out, int wv_) {
    int tid; { unsigned z_ = 0u; asm volatile("" : "+v"(z_)); tid = wv_ * 64 + (int)__builtin_amdgcn_mbcnt_hi(~0u, __builtin_amdgcn_mbcnt_lo(~0u, z_)); asm volatile("" : "+v"(tid)); }
    const int sub = tid & 15;
    const int npairs = SEQ * 16, step = (int)gridDim.x * 32;
    for (int p0 = (int)blockIdx.x * 32 + (tid >> 4); p0 < npairs; p0 += 2 * step) {
        u32x4 wa[2], wb[2], wc[2]; float l0[2], l1[2], l2[2]; size_t off[2];
#pragma unroll
        for (int u = 0; u < 2; ++u) { const int p = (p0 + u * step < npairs) ? p0 + u * step : p0; off[u] = (size_t)p * 128 + sub * 8;
            l0[u] = lse[p]; l1[u] = lse[(size_t)SEQ * 16 + p]; l2[u] = lse[(size_t)2 * SEQ * 16 + p];
            wa[u] = *(const u32x4*)(og + off[u]); wb[u] = *(const u32x4*)(og + (size_t)SEQ * DM + off[u]); wc[u] = *(const u32x4*)(og + (size_t)2 * SEQ * DM + off[u]); }
#pragma unroll
        for (int u = 0; u < 2; ++u) {
            const float m = fmaxf(l0[u], fmaxf(l1[u], l2[u]));
            float e0 = __expf(l0[u] - m), e1 = __expf(l1[u] - m), e2 = __expf(l2[u] - m); const float inv = 1.0f / (e0 + e1 + e2); e0 *= inv; e1 *= inv; e2 *= inv;
            float a[8], b[8], c[8], y[8];
            unpack8(wa[u], a); unpack8(wb[u], b); unpack8(wc[u], c);
#pragma unroll
            for (int j = 0; j < 8; ++j) y[j] = e0 * a[j] + e1 * b[j] + e2 * c[j];
            if (p0 + u * step < npairs) *(u32x4*)(out + off[u]) = pack8(y);
        }
    }
}

constexpr int LDS_BYTES = pg8::STAGE_BYTES + 64 + 8192;
__device__ __forceinline__ unsigned char* ldr(unsigned char* p) { unsigned lo = (unsigned)(uintptr_t)p, hi = (unsigned)((uintptr_t)p >> 32); lo = __builtin_amdgcn_readfirstlane(lo); hi = __builtin_amdgcn_readfirstlane(hi); asm volatile("" : "+s"(lo), "+s"(hi)); return (unsigned char*)(((uintptr_t)hi << 32) | lo); }
__global__ void __launch_bounds__(512, 2) fwd_kernel(Args a) {
    extern __shared__ __attribute__((aligned(16))) unsigned char shm[];
    LAS unsigned char* lds = (LAS unsigned char*)shm;
    volatile LAS unsigned* misc = (volatile LAS unsigned*)(lds + pg8::STAGE_BYTES);
    const int wv_ = __builtin_amdgcn_readfirstlane((int)(threadIdx.x >> 6));
    if (threadIdx.x < 16) misc[threadIdx.x] = 0u;
    __syncthreads();
    (void)xcd_barrier_post((unsigned*)(ws_fresh() + OFF_BAR), misc);
    cg::grid_group grid = cg::this_grid();
#define GRID_BAR() do { XcdBarrier b_; b_.bar = (unsigned*)(ws_fresh() + OFF_BAR); b_.x = xb_xcc_id(); b_.st = (volatile LAS unsigned*)(lds + pg8::STAGE_BYTES); xcd_barrier(b_, wv_); } while (0)
#define WSP(T, off) ((T*)(ws + (off)))
#define SLACK_PREP(lo_, hi_) do { if (bid >= G / 2) { const int D0_ = a.tile_start[NJOBS_MAIN], DE_ = a.tile_start[NJOBS]; const int nr_ = G - G / 2; \
        int b_ = D0_ + (lo_) * nr_, e_ = (hi_) < 0 ? DE_ : D0_ + (hi_) * nr_; if (b_ > DE_) b_ = DE_; if (e_ > DE_) e_ = DE_; \
        weight_tiles(a, lds, wv_, b_ + (bid - G / 2), e_, nr_, NJOBS_MAIN); } } while (0)

    prep_phase(a, lds, wv_);
    grid.sync();

    for (int layer = 0; layer < NLAYER; ++layer) {
        const int kind = layer % 3, slot = layer / 3;
        int G = gridDim.x, bid = blockIdx.x; asm volatile("" : "+s"(G), "+s"(bid));
        if (kind == 0) {
            { unsigned char* ws = ws_fresh(); const unsigned char* WA = ws + OFF_A + (size_t)slot * (SZ_AIN + SZ_WO);
              pg8::EpiQKNorm E{WSP(bf16_t, OFF_R1), 3072, WSP(float, OFF_SS) + (size_t)(3 * layer) * SEQ, 8, 10, a.in[12] + slot * 128, a.in[13] + slot * 128, WSP(const f32x2, OFF_R32), (LAS float*)(lds + pg8::STAGE_BYTES + 64)}; run_gemm(lds, WSP(bf16_t, OFF_HB), (const bf16_t*)WA, 3072, DM, E, wv_); }
            if (layer == 0) SLACK_PREP(0, 17); else SLACK_PREP(50, -1);
            GRID_BAR();
            { unsigned char* ws = ws_fresh(); bf16_t* QKV = WSP(bf16_t, OFF_R1); bf16_t* ATT = WSP(bf16_t, OFF_ATT);
              for (int it = bid; it < 512; it += G) {
                const int hq = it & 15, qb = it >> 4, kvh = hq >> 2;
#ifndef NO_ATT_A
                att::attn_body<128, 1, 1>(QKV + hq * 128, 3072, QKV + 2048 + kvh * 128, 3072, QKV + 2560 + kvh * 128, 3072, ATT + hq * 128, DM, nullptr, 0,
                                          qb * 256, qb * 256 - 128, 8, SEQ, 128, a.in[14][slot * 16 + hq], (char*)shm, wv_);
#endif
              } }
            GRID_BAR();
        } else if (kind == 1) {
            { unsigned char* ws = ws_fresh(); float* SS = WSP(float, OFF_SS);
              pg8::EpiScaleBf16 E{WSP(bf16_t, OFF_R1 + R1_LAT), 512, 512, (size_t)SEQ * 512, SS + (size_t)(3 * layer) * SEQ, 1.0f / DM, SS + (size_t)13 * SEQ, SS + (size_t)14 * SEQ};
              run_gemm(lds, WSP(bf16_t, OFF_HB), WSP(const bf16_t, OFF_B), 1280, DM, E, wv_); }
            GRID_BAR();
            { unsigned char* ws = ws_fresh();
              pg8::EpiScaleBf16 E{WSP(bf16_t, OFF_R1 + R1_QRAW), 3072, 0, 0, WSP(float, OFF_SS) + (size_t)13 * SEQ, 1.0f / 512.0f, nullptr, nullptr};
              run_gemm(lds, WSP(bf16_t, OFF_R1 + R1_LAT), WSP(const bf16_t, OFF_B + SZ_BIN), 3072, 512, E, wv_); }
            { unsigned char* ws = ws_fresh();
              pg8::EpiScaleBf16 E{WSP(bf16_t, OFF_R1 + R1_KVRAW), 4096, 0, 0, WSP(float, OFF_SS) + (size_t)14 * SEQ, 1.0f / 512.0f, nullptr, nullptr};
              run_gemm(lds, WSP(bf16_t, OFF_R1 + R1_LAT) + (size_t)SEQ * 512, WSP(const bf16_t, OFF_B + SZ_BIN + SZ_BQ), 4096, 512, E, wv_); }
            GRID_BAR();
            { unsigned char* ws = ws_fresh();
              post_b(WSP(bf16_t, OFF_R1 + R1_QRAW), WSP(bf16_t, OFF_R1 + R1_KVRAW), WSP(bf16_t, OFF_R1 + R1_LAT) + (size_t)2 * SEQ * 512, WSP(bf16_t, OFF_R1 + R1_KB), a.in[21], a.in[22], WSP(const f32x2, OFF_R64), wv_); }
            GRID_BAR();
            { unsigned char* ws = ws_fresh(); bf16_t* QRAW = WSP(bf16_t, OFF_R1 + R1_QRAW); bf16_t* KVRAW = WSP(bf16_t, OFF_R1 + R1_KVRAW); bf16_t* KB = WSP(bf16_t, OFF_R1 + R1_KB); bf16_t* ATT = WSP(bf16_t, OFF_ATT);
              for (int it = bid; it < 512; it += G) {
                const int hq = (it & 7) + 8 * (it >> 8), qb = (it >> 3) & 31;
#ifndef NO_ATT_B
                att::attn_body<192, 0, 1>(QRAW + hq * 192, 3072, KB + hq * 192, 3072, KVRAW + hq * 256 + 128, 4096, ATT + hq * 128, DM, nullptr, 0,
                                          qb * 256, 0, 128, SEQ, 0, 0.f, (char*)shm, wv_);
#endif
              } }
            GRID_BAR();
        } else {
            { unsigned char* ws = ws_fresh();
              pg8::EpiQKNorm E{WSP(bf16_t, OFF_R1), 10240, WSP(float, OFF_SS) + (size_t)(3 * layer) * SEQ, 24, 32, a.in[25], a.in[26], WSP(const f32x2, OFF_R32), (LAS float*)(lds + pg8::STAGE_BYTES + 64)}; run_gemm(lds, WSP(bf16_t, OFF_HB), WSP(const bf16_t, OFF_C), 10240, DM, E, wv_); }
            GRID_BAR();
            { unsigned char* ws = ws_fresh(); bf16_t* QKV = WSP(bf16_t, OFF_R1); bf16_t* OG = WSP(bf16_t, OFF_OG); float* LSE = WSP(float, OFF_LSE);
              for (int it = bid; it < 1536; it += G) {
                const int g = it >> 9, r = it & 511, hq = r & 15, rest = r >> 4;
                const int dl = g == 0 ? 0 : (g == 1 ? 2 : 4), dil = 1 << dl, Lc = SEQ >> dl, nqb = Lc >> 8;
                const int ch = rest / nqb, qb = rest - ch * nqb;
#ifndef NO_ATT_C
                att::attn_body<128, 2, 1>(QKV + (size_t)ch * 10240 + (g * 16 + hq) * 128, (long)dil * 10240, QKV + (size_t)ch * 10240 + 6144 + hq * 128, (long)dil * 10240,
                                          QKV + (size_t)ch * 10240 + 8192 + hq * 128, (long)dil * 10240, OG + (size_t)g * SEQ * DM + (size_t)ch * DM + hq * 128, (long)dil * DM,
                                          LSE + (size_t)g * SEQ * 16 + ch * 16 + hq, (long)dil * 16, qb * 256, qb * 256 - 64, 6, Lc, 64, 0.f, (char*)shm, wv_);
#endif
              } }
            GRID_BAR();
            { unsigned char* ws = ws_fresh(); merge_c(WSP(bf16_t, OFF_OG), WSP(float, OFF_LSE), WSP(bf16_t, OFF_ATT), wv_); }
            GRID_BAR();
        }
        { unsigned char* ws = ws_fresh();
          const size_t wo = kind == 0 ? OFF_A + (size_t)slot * (SZ_AIN + SZ_WO) + SZ_AIN : (kind == 1 ? OFF_B + SZ_BIN + SZ_BQ + SZ_BKV : OFF_C + SZ_CIN);
          pg8::EpiResid E{layer == 0 ? a.in[0] : a.out, a.out, WSP(bf16_t, OFF_HB), nullptr, nullptr, WSP(float, OFF_SS) + (size_t)(3 * layer + 1) * SEQ}; run_gemm(lds, WSP(bf16_t, OFF_ATT), (const bf16_t*)(ws + wo), DM, DM, E, wv_); }
        GRID_BAR();
        { unsigned char* ws = ws_fresh();
          pg8::EpiSwiglu E{WSP(bf16_t, OFF_R1), WSP(float, OFF_SS) + (size_t)(3 * layer + 1) * SEQ}; run_gemm(lds, WSP(bf16_t, OFF_HB), (const bf16_t*)(ws + OFF_WL + (size_t)layer * SZ_LAYER), 11264, DM, E, wv_); }
        if ((int)blockIdx.x >= G / 2) {
          unsigned char* ws = ws_fresh();
          pg8::EpiScaleBf16 E{WSP(bf16_t, OFF_PP), DM, 0, 0, nullptr, 0.f, nullptr, nullptr};
          pg8::Gemm g{WSP(bf16_t, OFF_PBF) + (size_t)layer * SEQ * PLE, (const bf16_t*)(ws + OFF_WL + (size_t)layer * SZ_LAYER + SZ_WGU + SZ_WD + SZ_WPG), SEQ, DM, PLE};
          pg8::StaticOrder S; S.init(SEQ, DM, G - G / 2, (int)blockIdx.x - G / 2);
          pg8::gemm_phase<pg8::EpiScaleBf16, pg8::StaticOrder>(lds, g, S, E, wv_); }
        if (layer < 3) { const int lo_s = layer == 0 ? 17 : (layer == 1 ? 28 : 39), hi_s = layer == 0 ? 28 : (layer == 1 ? 39 : 50); SLACK_PREP(lo_s, hi_s); }
        GRID_BAR();
        { unsigned char* ws = ws_fresh();
          pg8::EpiResid E{a.out, a.out, WSP(bf16_t, OFF_HB), nullptr, nullptr, WSP(float, OFF_SS) + (size_t)(3 * layer + 2) * SEQ}; run_gemm(lds, WSP(bf16_t, OFF_R1), (const bf16_t*)(ws + OFF_WL + (size_t)layer * SZ_LAYER + SZ_WGU), DM, FF, E, wv_); }
        GRID_BAR();
        { unsigned char* ws = ws_fresh();
          pg8::EpiPle E{a.out, a.out, WSP(bf16_t, OFF_HB), WSP(bf16_t, OFF_PP), WSP(float, OFF_SS) + (size_t)(3 * layer + 2) * SEQ, WSP(float, OFF_SS) + (size_t)(3 * layer + 3) * SEQ};
          run_gemm(lds, WSP(bf16_t, OFF_HB), (const bf16_t*)(ws + OFF_WL + (size_t)layer * SZ_LAYER + SZ_WGU + SZ_WD), DM, DM, E, wv_); }
        if (layer + 1 < NLAYER) GRID_BAR();
    }
}

extern "C" void kernel_launch(void* const* d_in, const int* in_sizes, int n_in, void* d_out, int out_size, void* d_ws, size_t ws_size, hipStream_t stream) {
    static int grid = 0;
    if (grid == 0) {
        if (n_in != 28 || out_size != SEQ * DM || ws_size < WS_END) { fprintf(stderr, "kernel_launch: unexpected shapes: n_in %d out %d ws %zu (need %zu)\n", n_in, out_size, ws_size, (size_t)WS_END); grid = -1; return; }
        int dev = 0, cus = 0, per_cu = 0;
        if (hipGetDevice(&dev) != hipSuccess || hipDeviceGetAttribute(&cus, hipDeviceAttributeMultiprocessorCount, dev) != hipSuccess) { grid = -1; return; }
        if (hipFuncSetAttribute((const void*)fwd_kernel, hipFuncAttributeMaxDynamicSharedMemorySize, LDS_BYTES) != hipSuccess) { fprintf(stderr, "kernel_launch: hipFuncSetAttribute failed\n"); grid = -1; return; }
        if (hipOccupancyMaxActiveBlocksPerMultiprocessor(&per_cu, (const void*)fwd_kernel, 512, LDS_BYTES) != hipSuccess || per_cu < 1) { fprintf(stderr, "kernel_launch: occupancy query says %d\n", per_cu); (void)hipGetLastError(); per_cu = 1; }
        grid = cus * 1;
    }
    if (grid < 0) return;
    (void)hipMemsetAsync((char*)d_ws + OFF_BAR, 0, 16384, stream);
    Args a{};
    for (int i = 0; i < 28; ++i) a.in[i] = (const float*)d_in[i];
    a.out = (float*)d_out; a.ws = (unsigned char*)d_ws;
    for (int i = 0; i < 16; ++i) a.inv32[i] = std::pow(500000.0, -(double)i * 2.0 / 32.0);
    for (int i = 0; i < 32; ++i) a.inv64[i] = std::pow(500000.0, -(double)i * 2.0 / 64.0);
    int nj = 0;
    auto add = [&](const float* src, const float* gain, size_t dst, int K, int N, int Npad, int blk, int blkstride, int boff) {
        WJob& J = a.jobs[nj++]; J.src = src; J.gain = gain; J.dst_off = dst; J.K = K; J.N = N; J.Npad = Npad; J.blk = blk; J.blkstride = blkstride; J.boff = boff; };
    const float* const* in = (const float* const*)d_in;
    auto add_layer = [&](int i) {
        const size_t wl = OFF_WL + (size_t)i * SZ_LAYER;
        add(in[8] + (size_t)i * DM * FF, in[4] + i * DM, wl, DM, FF, FF, 128, 256, 0);
        add(in[9] + (size_t)i * DM * FF, in[4] + i * DM, wl, DM, FF, FF, 128, 256, 128);
        add(in[10] + (size_t)i * FF * DM, nullptr, wl + SZ_WGU, FF, DM, DM, DM, 0, 0);
        add(in[6] + (size_t)i * DM * DM, in[5] + i * DM, wl + SZ_WGU + SZ_WD, DM, DM, DM, DM, 0, 0);
        add(in[7] + (size_t)i * PLE * DM, nullptr, wl + SZ_WGU + SZ_WD + SZ_WPG, PLE, DM, DM, DM, 0, 0);
    };
    auto add_a = [&](int sl) {
        const size_t wa = OFF_A + (size_t)sl * (SZ_AIN + SZ_WO);
        add(in[11] + (size_t)sl * DM * 3072, in[3] + (3 * sl) * DM, wa, DM, 3072, 3072, 3072, 0, 0);
        add(in[15] + (size_t)sl * DM * DM, nullptr, wa + SZ_AIN, DM, DM, DM, DM, 0, 0);
    };
    add_layer(0); add_layer(1); add_a(0);
    add(in[16], in[3] + 1 * DM, OFF_B, DM, 1088, 1280, 1280, 0, 0);
    add(in[19], in[17], OFF_B + SZ_BIN, 512, 3072, 3072, 3072, 0, 0);
    add(in[20], in[18], OFF_B + SZ_BIN + SZ_BQ, 512, 4096, 4096, 4096, 0, 0);
    add(in[23], nullptr, OFF_B + SZ_BIN + SZ_BQ + SZ_BKV, DM, DM, DM, DM, 0, 0);
    add(in[24], in[3] + 2 * DM, OFF_C, DM, 10240, 10240, 10240, 0, 0);
    add(in[27], nullptr, OFF_C + SZ_CIN, DM, DM, DM, DM, 0, 0);
    { const int i = 2; const size_t wl = OFF_WL + (size_t)i * SZ_LAYER;
      add(in[10] + (size_t)i * FF * DM, nullptr, wl + SZ_WGU, FF, DM, DM, DM, 0, 0);
      add(in[6] + (size_t)i * DM * DM, in[5] + i * DM, wl + SZ_WGU + SZ_WD, DM, DM, DM, DM, 0, 0);
      add(in[7] + (size_t)i * PLE * DM, nullptr, wl + SZ_WGU + SZ_WD + SZ_WPG, PLE, DM, DM, DM, 0, 0);
      add(in[8] + (size_t)i * DM * FF, in[4] + i * DM, wl, DM, FF, FF, 128, 256, 0);
      add(in[9] + (size_t)i * DM * FF, in[4] + i * DM, wl, DM, FF, FF, 128, 256, 128); }
    add_a(1); add_layer(3);
    a.tile_start[0] = 0;
    for (int j = 0; j < NJOBS; ++j) a.tile_start[j + 1] = a.tile_start[j] + (a.jobs[j].K / 128) * (a.jobs[j].Npad / 64);
    a.tile_start[NJOBS + 1] = 0x7fffffff;
    void* args[] = {&a};
    hipError_t e = hipLaunchCooperativeKernel((const void*)fwd_kernel, dim3(grid), dim3(512), args, LDS_BYTES, stream);
    if (e != hipSuccess) fprintf(stderr, "kernel_launch: cooperative launch failed: %s (grid %d)\n", hipGetErrorString(e), grid);
}
```
